# Optimizing an MI355X kernel written in HIP

```python
import math
import jax, jax.numpy as jnp
from jax import lax
import numpy as np


D_MODEL = 1024
BATCH = 1
SEQ = 16384
DEPTH = 4
DEC_BATCH = 8
DEC_SEQ = 2048
PAST_LEN = 128

GRID_W = 64
N_HEADS = 8
N_KV_HEADS = 2
HEAD_DIM = 64
GROUP = N_HEADS // N_KV_HEADS
ROPE_THETA = 10000.0
ROPE_AXIS_DIM = HEAD_DIM // 2
Q_BLOCK = 128
ATT_W = N_HEADS * HEAD_DIM
KV_W = N_KV_HEADS * HEAD_DIM
HY_W = D_MODEL // 2
HY_EMB = 33
HY_BANDS = (HY_EMB - 1) // 2
HY_FILTER_W = 64
HY_TARGET = 1e-2
HY_FAST = 0.3
HY_SLOW = 1.5
GLA_HEADS = 4
GLA_DK = 64
GLA_DV = 128
GLA_K = GLA_HEADS * GLA_DK
GLA_V = GLA_HEADS * GLA_DV
GLA_RANK = 16
GLA_TAU = 16.0
GLA_CHUNK = 64
N_BRANCH = 3
MIX_W = 512
D_FF = 2816
EPS = 1e-6
IN_SIZES = (ATT_W, KV_W, KV_W, 3 * HY_W, GLA_K, GLA_K, GLA_V, GLA_V, 2 * GLA_RANK, N_BRANCH * D_MODEL)
IN_COLS = ATT_W + 2 * KV_W + 3 * HY_W + 2 * GLA_K + 2 * GLA_V + 2 * GLA_RANK + N_BRANCH * D_MODEL

kernel_name = 'hybrid_bidir_encoder'


def rms_norm(x, g):
    xf = x.astype(jnp.float32)
    y = xf * lax.rsqrt(jnp.mean(xf * xf, axis=-1, keepdims=True) + EPS)
    return (y * g.astype(jnp.float32)).astype(x.dtype)


def split_cols(z):
    out = []
    off = 0
    for s in IN_SIZES:
        out.append(z[..., off:off + s])
        off += s
    return out


def axial_rope(L):
    rows = L // GRID_W
    r = jnp.repeat(jnp.arange(rows, dtype=jnp.float32), GRID_W)
    c = jnp.tile(jnp.arange(GRID_W, dtype=jnp.float32), rows)
    inv = ROPE_THETA ** (-jnp.arange(0, ROPE_AXIS_DIM, 2, dtype=jnp.float32) / ROPE_AXIS_DIM)
    ang = jnp.concatenate([r[:, None] * inv, c[:, None] * inv], axis=-1)
    return jnp.cos(ang), jnp.sin(ang)


def apply_rope(x, cos, sin):
    half = HEAD_DIM // 2
    x1, x2 = x[..., :half], x[..., half:]
    return jnp.concatenate([x1 * cos - x2 * sin, x1 * sin + x2 * cos], axis=-1)


def gqa_attention(q, k, v, q_norm_g, k_norm_g, cos, sin):
    B, L, _ = q.shape
    q = rms_norm(q.astype(jnp.float32).reshape(B, L, N_KV_HEADS, GROUP, HEAD_DIM), q_norm_g)
    k = rms_norm(k.astype(jnp.float32).reshape(B, L, N_KV_HEADS, HEAD_DIM), k_norm_g)
    v = v.reshape(B, L, N_KV_HEADS, HEAD_DIM)
    q = apply_rope(q, cos[None, :, None, None, :], sin[None, :, None, None, :])
    k = apply_rope(k, cos[None, :, None, :], sin[None, :, None, :])
    nb = L // Q_BLOCK
    qb = jnp.moveaxis(q.reshape(B, nb, Q_BLOCK, N_KV_HEADS, GROUP, HEAD_DIM), 1, 0)
    scale = HEAD_DIM ** -0.5

    def block(qi):
        s = jnp.einsum('bqkgd,bskd->bkgqs', qi, k) * scale
        p = jax.nn.softmax(s, axis=-1)
        return jnp.einsum('bkgqs,bskd->bqkgd', p.astype(v.dtype), v)

    o = lax.map(block, qb)
    return jnp.moveaxis(o, 0, 1).reshape(B, L, ATT_W).astype(v.dtype)


def short_conv3(u, w, b):
    up = jnp.pad(u, ((0, 0), (1, 1), (0, 0)))
    return up[:, :-2] * w[0] + up[:, 1:-1] * w[1] + up[:, 2:] * w[2] + b


def hyena_filter(L, w1, b1, f1, w2, b2, f2, w3):
    f32 = jnp.float32
    t = jnp.linspace(0.0, 1.0, L, dtype=f32)[:, None]
    w = 2.0 * math.pi * jnp.arange(L, dtype=f32) / L
    fb = jnp.linspace(1e-4, HY_BANDS - 1, HY_BANDS, dtype=f32)
    ph = w[:, None] * fb
    feats = jnp.concatenate([t, jnp.cos(ph), -jnp.sin(ph)], axis=-1)
    h = jnp.sin(f1.astype(f32) * (feats @ w1.astype(f32) + b1.astype(f32)))
    h = jnp.sin(f2.astype(f32) * (h @ w2.astype(f32) + b2.astype(f32)))
    h = h @ w3.astype(f32)
    deltas = jnp.linspace(abs(math.log(HY_TARGET) / HY_SLOW), abs(math.log(HY_TARGET) / HY_FAST), HY_W, dtype=f32)
    decay = jnp.exp(-t * deltas)
    hf = h[:, :HY_W] * decay
    hb = h[:, HY_W:] * decay
    kf = jnp.concatenate([hf, jnp.zeros((1, HY_W), f32), jnp.flip(hb[1:], axis=0)], axis=0)
    return kf * lax.rsqrt(jnp.sum(kf * kf, axis=0, keepdims=True) + EPS)


def hyena_mixer(z, conv_w, conv_b, w1, b1, f1, w2, b2, f2, w3, skip):
    B, L, _ = z.shape
    zc = short_conv3(z, conv_w, conv_b)
    v, x1, x2 = jnp.split(zc, 3, axis=-1)
    kf = hyena_filter(L, w1, b1, f1, w2, b2, f2, w3)
    u = (v * x1).astype(jnp.float32)
    U = jnp.fft.rfft(u, n=2 * L, axis=1)
    K = jnp.fft.rfft(kf, n=2 * L, axis=0)
    y = jnp.fft.irfft(U * K[None], n=2 * L, axis=1)[:, :L] + u * skip.astype(jnp.float32)
    return (x2.astype(jnp.float32) * y).astype(z.dtype)


def gla_chunked(q, k, v, log_a, include_diag):
    B, L, H, DK = q.shape
    DV = v.shape[-1]
    C = GLA_CHUNK
    nc = L // C
    q = q.reshape(B, nc, C, H, DK)
    k = k.reshape(B, nc, C, H, DK)
    v = v.reshape(B, nc, C, H, DV)
    b = jnp.cumsum(log_a.reshape(B, nc, C, H, DK), axis=2)
    b_mid = b[:, :, C // 2 - 1:C // 2]
    A = jnp.einsum('bnihd,bnjhd->bnhij', q * jnp.exp(b - b_mid), k * jnp.exp(b_mid - b))
    mask = jnp.tril(jnp.ones((C, C), dtype=bool), k=0 if include_diag else -1)
    A = jnp.where(mask, A, 0.0)
    o_intra = jnp.einsum('bnhij,bnjhv->bnihv', A, v)
    b_last = b[:, :, C - 1:]
    U = jnp.einsum('bnjhd,bnjhv->nbhdv', k * jnp.exp(b_last - b), v)
    decay = jnp.moveaxis(jnp.exp(b_last[:, :, 0]), 1, 0)

    def step(S, inp):
        d, u = inp
        return d[..., None] * S + u, S

    _, S_prev = lax.scan(step, jnp.zeros((B, H, DK, DV), jnp.float32), (decay, U))
    o_inter = jnp.einsum('bnihd,nbhdv->bnihv', q * jnp.exp(b), S_prev)
    return (o_intra + o_inter).reshape(B, L, H, DV)


def gla_mixer(q, k, v, og, glow, gate_up, gate_b, norm_g):
    B, L, _ = q.shape
    f32 = jnp.float32
    q = q.astype(f32).reshape(B, L, GLA_HEADS, GLA_DK) * (GLA_DK ** -0.5)
    k = k.astype(f32).reshape(B, L, GLA_HEADS, GLA_DK)
    v = v.astype(f32).reshape(B, L, GLA_HEADS, GLA_DV)
    lo = glow.astype(f32).reshape(B, L, 2, GLA_RANK)
    logit = jnp.einsum('blnr,nrk->blnk', lo, gate_up.astype(f32)) + gate_b.astype(f32)
    log_a = jax.nn.log_sigmoid(logit) / GLA_TAU
    la_f = log_a[:, :, 0].reshape(B, L, GLA_HEADS, GLA_DK)
    la_b = log_a[:, :, 1].reshape(B, L, GLA_HEADS, GLA_DK)
    o_f = gla_chunked(q, k, v, la_f, True)
    o_b = jnp.flip(gla_chunked(jnp.flip(q, 1), jnp.flip(k, 1), jnp.flip(v, 1), jnp.flip(la_b, 1), False), axis=1)
    o = rms_norm(o_f + o_b, norm_g)
    o = o * jax.nn.silu(og.astype(f32)).reshape(B, L, GLA_HEADS, GLA_DV)
    return o.reshape(B, L, GLA_V).astype(og.dtype)


def encoder_layer(x, norm_mix_g, w_in, q_norm_g, k_norm_g, hy_conv_w, hy_conv_b, hy_w1, hy_b1, hy_f1, hy_w2, hy_b2, hy_f2, hy_w3, hy_skip, gla_gate_up, gla_gate_b, gla_norm_g, w_branch, w_out, norm_ffn_g, w_ffn_gate, w_ffn_up, w_ffn_down):
    B, L, _ = x.shape
    h = rms_norm(x, norm_mix_g)
    z = h @ w_in
    aq, ak, av, hz, gq, gk, gv, gog, glow, gates = split_cols(z)
    cos, sin = axial_rope(L)
    y_att = gqa_attention(aq, ak, av, q_norm_g, k_norm_g, cos, sin)
    y_hy = hyena_mixer(hz, hy_conv_w, hy_conv_b, hy_w1, hy_b1, hy_f1, hy_w2, hy_b2, hy_f2, hy_w3, hy_skip)
    y_gla = gla_mixer(gq, gk, gv, gog, glow, gla_gate_up, gla_gate_b, gla_norm_g)
    ys = jnp.stack([y_att, y_hy, y_gla], axis=2)
    proj = jnp.einsum('blnc,ncd->blnd', ys, w_branch)
    g = jax.nn.sigmoid(gates.reshape(B, L, N_BRANCH, D_MODEL))
    merged = jnp.sum(g * proj, axis=2)
    x = x + merged @ w_out
    h = rms_norm(x, norm_ffn_g)
    x = x + (jax.nn.silu(h @ w_ffn_gate) * (h @ w_ffn_up)) @ w_ffn_down
    return x


def setup_inputs(seed: int = 0) -> dict:
    key = jax.random.key(seed)
    ks = jax.random.split(key, 28)
    f32 = jnp.float32

    def nrm(k, shape, scale):
        return jax.random.normal(k, shape, f32) * scale

    return {
        'x_prompt': nrm(ks[0], (BATCH, SEQ, D_MODEL), 1.0),
        'x_sample': nrm(ks[1], (DEC_BATCH, DEC_SEQ, D_MODEL), 1.0),
        'norm_mix_g': 1.0 + nrm(ks[2], (DEPTH, D_MODEL), 0.01),
        'w_in': nrm(ks[3], (DEPTH, D_MODEL, IN_COLS), D_MODEL ** -0.5),
        'q_norm_g': 1.0 + nrm(ks[4], (DEPTH, HEAD_DIM), 0.01),
        'k_norm_g': 1.0 + nrm(ks[5], (DEPTH, HEAD_DIM), 0.01),
        'hy_conv_w': nrm(ks[6], (DEPTH, 3, 3 * HY_W), 3 ** -0.5),
        'hy_conv_b': nrm(ks[7], (DEPTH, 3 * HY_W), 0.01),
        'hy_w1': nrm(ks[8], (DEPTH, HY_EMB, HY_FILTER_W), HY_EMB ** -0.5),
        'hy_b1': nrm(ks[9], (DEPTH, HY_FILTER_W), 0.1),
        'hy_f1': 1.0 + nrm(ks[10], (DEPTH, HY_FILTER_W), 0.01),
        'hy_w2': nrm(ks[11], (DEPTH, HY_FILTER_W, HY_FILTER_W), HY_FILTER_W ** -0.5),
        'hy_b2': nrm(ks[12], (DEPTH, HY_FILTER_W), 0.1),
        'hy_f2': 1.0 + nrm(ks[13], (DEPTH, HY_FILTER_W), 0.01),
        'hy_w3': nrm(ks[14], (DEPTH, HY_FILTER_W, 2 * HY_W), HY_FILTER_W ** -0.5),
        'hy_skip': nrm(ks[15], (DEPTH, HY_W), 0.5),
        'gla_gate_up': nrm(ks[16], (DEPTH, 2, GLA_RANK, GLA_K), GLA_RANK ** -0.5),
        'gla_gate_b': nrm(ks[17], (DEPTH, 2, GLA_K), 0.1),
        'gla_norm_g': 1.0 + nrm(ks[18], (DEPTH, GLA_DV), 0.01),
        'w_branch': nrm(ks[19], (DEPTH, N_BRANCH, MIX_W, D_MODEL), MIX_W ** -0.5),
        'w_out': nrm(ks[20], (DEPTH, D_MODEL, D_MODEL), D_MODEL ** -0.5),
        'norm_ffn_g': 1.0 + nrm(ks[21], (DEPTH, D_MODEL), 0.01),
        'w_ffn_gate': nrm(ks[22], (DEPTH, D_MODEL, D_FF), D_MODEL ** -0.5),
        'w_ffn_up': nrm(ks[23], (DEPTH, D_MODEL, D_FF), D_MODEL ** -0.5),
        'w_ffn_down': nrm(ks[24], (DEPTH, D_FF, D_MODEL), D_FF ** -0.5),
        'final_norm_g': 1.0 + nrm(ks[25], (D_MODEL,), 0.01),
    }


def reference(x_prompt, x_sample, norm_mix_g, w_in, q_norm_g, k_norm_g, hy_conv_w, hy_conv_b, hy_w1, hy_b1, hy_f1, hy_w2, hy_b2, hy_f2, hy_w3, hy_skip, gla_gate_up, gla_gate_b, gla_norm_g, w_branch, w_out, norm_ffn_g, w_ffn_gate, w_ffn_up, w_ffn_down, final_norm_g):
    xp = x_prompt
    xs = x_sample
    for l in range(DEPTH):
        p = (norm_mix_g[l], w_in[l], q_norm_g[l], k_norm_g[l], hy_conv_w[l], hy_conv_b[l], hy_w1[l], hy_b1[l], hy_f1[l], hy_w2[l], hy_b2[l], hy_f2[l], hy_w3[l], hy_skip[l], gla_gate_up[l], gla_gate_b[l], gla_norm_g[l], w_branch[l], w_out[l], norm_ffn_g[l], w_ffn_gate[l], w_ffn_up[l], w_ffn_down[l])
        xp = encoder_layer(xp, *p)
        xs = encoder_layer(xs, *p)
    y_prompt = rms_norm(xp, final_norm_g)
    y_sample = rms_norm(xs, final_norm_g)
    return (y_prompt, y_sample)
```

```cpp
#include <hip/hip_runtime.h>
#include <hip/hip_cooperative_groups.h>
#include <stdint.h>
#include <stdio.h>
namespace cg = cooperative_groups;

typedef unsigned short bf16;
typedef __attribute__((ext_vector_type(8))) short s8v;
typedef __attribute__((ext_vector_type(4))) short s4v;
typedef __attribute__((ext_vector_type(16))) float f16v;
typedef __attribute__((ext_vector_type(4))) unsigned u4v;
typedef __attribute__((ext_vector_type(2))) unsigned u2v;

#define MFMA(a, b, c) __builtin_amdgcn_mfma_f32_32x32x16_bf16((a), (b), (c), 0, 0, 0)

#define T_TOK 32768
#define LP 16384
#define LS 2048
#define DM 1024
#define EPSF 1e-6f
#define NPH_LAYER 10
#define PROBE_PHASE -1
#define PROBE_SUB 2
#ifndef N_LAUNCH_MODE
#define N_LAUNCH_MODE 1
#endif

struct Params {
  const float* in[26];
  float* out;
  bf16 *WinT, *WgT, *WbT, *WoT, *WfguT, *WfdT;
  bf16 *h, *q, *k, *vT, *hv, *hx1, *hx2, *gq, *gk, *gv, *gog;
  float* glow;
  bf16 *uT, *rhoP, *rhoS;
  bf16* gstate;
  float* gdecay;
  bf16 *of, *merged, *act;
  float* sumsq;
  unsigned* counters;
  unsigned* bar;
  int dryflag, pad_;
};

typedef __bf16 bf2_t __attribute__((ext_vector_type(2)));
typedef float f2_t __attribute__((ext_vector_type(2)));
__device__ __forceinline__ bf16 f2bf(float f) { return __builtin_bit_cast(unsigned short, (__bf16)f); }
__device__ __forceinline__ int tid_opaque() { int t = threadIdx.x; asm volatile("" : "+v"(t)); return t; }
__device__ __forceinline__ float bf2f(bf16 b) { return __uint_as_float(((unsigned)b) << 16); }
__device__ __forceinline__ unsigned pack2(float a, float b) { f2_t f = {a, b}; return __builtin_bit_cast(unsigned, __builtin_convertvector(f, bf2_t)); }
__device__ __forceinline__ float sin_rev(float rev) { rev -= rintf(rev); return __builtin_amdgcn_sinf(rev); }
__device__ __forceinline__ float cos_rev(float rev) { rev -= rintf(rev); return __builtin_amdgcn_cosf(rev); }
__device__ __forceinline__ float sin_rad(float x) { return sin_rev(x * 0.15915494309189535f); }
__device__ __forceinline__ float fexp(float x) { return __builtin_amdgcn_exp2f(x * 1.4426950408889634f); }
__device__ __forceinline__ float sigmoidf_(float x) { return __builtin_amdgcn_rcpf(1.f + fexp(-x)); }
__device__ __forceinline__ float siluf_(float x) { return x * __builtin_amdgcn_rcpf(1.f + fexp(-x)); }
__device__ __forceinline__ int tok_pos(int t) { return t < LP ? t : ((t - LP) & (LS - 1)); }
__device__ __forceinline__ int tok_len(int t) { return t < LP ? LP : LS; }

__device__ __forceinline__ s8v pack8(const f16v& v, int s) {
  union { s8v v8; unsigned u[4]; } r;
  r.u[0] = pack2(v[8 * s + 0], v[8 * s + 1]);
  r.u[1] = pack2(v[8 * s + 2], v[8 * s + 3]);
  r.u[2] = pack2(v[8 * s + 4], v[8 * s + 5]);
  r.u[3] = pack2(v[8 * s + 6], v[8 * s + 7]);
  return r.v8;
}
__device__ __forceinline__ s8v ld2x64(const bf16* p0, const bf16* p1) {
  union { s8v v8; u2v u[2]; } r;
  r.u[0] = *(const u2v*)p0;
  r.u[1] = *(const u2v*)p1;
  return r.v8;
}

__device__ __forceinline__ int fetch_item(unsigned* ctr, int* s_item) {
  __syncthreads();
  if (threadIdx.x == 0) *s_item = (int)atomicAdd(ctr, 1u);
  __syncthreads();
  return *s_item;
}

#define ROW_OF(reg, hh) (((reg) & 3) + 8 * ((reg) >> 2) + 4 * (hh))

__device__ __forceinline__ void phase_norm(const Params& p, const float* g, bool from_input, bool final_out) {
  const int wave = tid_opaque() >> 6, lane = tid_opaque() & 63;
  for (int row0 = (blockIdx.x * 4 + wave) * 2; row0 < T_TOK; row0 += gridDim.x * 8) {
    float4 v[2][4];
    float ss[2] = {0.f, 0.f};
#pragma unroll
    for (int q = 0; q < 2; ++q) {
      const int row = row0 + q;
      const float* xr = from_input ? (row < LP ? p.in[0] + (size_t)row * DM : p.in[1] + (size_t)(row - LP) * DM)
                                   : p.out + (size_t)row * DM;
#pragma unroll
      for (int i = 0; i < 4; ++i) v[q][i] = ((const float4*)xr)[lane + 64 * i];
    }
#pragma unroll
    for (int q = 0; q < 2; ++q) {
#pragma unroll
      for (int i = 0; i < 4; ++i) ss[q] += v[q][i].x * v[q][i].x + v[q][i].y * v[q][i].y + v[q][i].z * v[q][i].z + v[q][i].w * v[q][i].w;
#pragma unroll
      for (int o = 1; o < 64; o <<= 1) ss[q] += __shfl_xor(ss[q], o);
    }
#pragma unroll
    for (int q = 0; q < 2; ++q) {
      const int row = row0 + q;
      const float rs = rsqrtf(ss[q] * (1.f / DM) + EPSF);
#pragma unroll
      for (int i = 0; i < 4; ++i) {
        float4 g4 = ((const float4*)g)[lane + 64 * i];
        float a = v[q][i].x * rs * g4.x, bb = v[q][i].y * rs * g4.y, c = v[q][i].z * rs * g4.z, d = v[q][i].w * rs * g4.w;
        if (final_out) {
          ((float4*)(p.out + (size_t)row * DM))[lane + 64 * i] = make_float4(a, bb, c, d);
        } else {
          u2v o2;
          o2.x = pack2(a, bb);
          o2.y = pack2(c, d);
          *(u2v*)(p.h + (size_t)row * DM + (lane + 64 * i) * 4) = o2;
        }
      }
    }
  }
}

#define CONV_ITEMS 4512
__device__ __forceinline__ void conv_tile(const Params& p, int layer, int item, float* sT) {
  const float* src;
  const float* src2 = nullptr;
  int ld, K, col0 = 0, nvalid, mode = 0, nt, kt;
  bf16* dst;
  if (item < 992) {
    nt = item >> 4; kt = item & 15; src = p.in[3] + (size_t)layer * 1024 * 6944; ld = 6944; K = 1024; nvalid = 3872; dst = p.WinT;
  } else if (item < 1760) {
    int it = item - 992; nt = it >> 4; kt = it & 15; src = p.in[3] + (size_t)layer * 1024 * 6944; ld = 6944; K = 1024; col0 = 3872; nvalid = 3072; dst = p.WgT;
  } else if (item < 2144) {
    int it = item - 1760; int b = it >> 7; it &= 127; nt = it >> 3; kt = it & 7;
    src = p.in[19] + (size_t)(layer * 3 + b) * 512 * 1024; ld = 1024; K = 512; nvalid = 1024; dst = p.WbT + (size_t)b * 1024 * 512;
  } else if (item < 2400) {
    int it = item - 2144; nt = it >> 4; kt = it & 15; src = p.in[20] + (size_t)layer * 1024 * 1024; ld = 1024; K = 1024; nvalid = 1024; dst = p.WoT;
  } else if (item < 3808) {
    int it = item - 2400; nt = it >> 4; kt = it & 15; mode = 1; src = p.in[22] + (size_t)layer * 1024 * 2816; src2 = p.in[23] + (size_t)layer * 1024 * 2816;
    ld = 2816; K = 1024; nvalid = 5632; dst = p.WfguT;
  } else {
    int it = item - 3808; nt = it / 44; kt = it % 44; src = p.in[24] + (size_t)layer * 2816 * 1024; ld = 1024; K = 2816; nvalid = 1024; dst = p.WfdT;
  }
  const int tid = tid_opaque();
  {
    const int n = tid & 63, kq = tid >> 6;
    const int j = nt * 64 + n;
    const float* sp = src;
    int col = col0 + j;
    bool valid = j < nvalid;
    if (mode == 1) {
      int blk = j >> 7, wn = (j >> 6) & 1, ni = (j >> 5) & 1, c = j & 31;
      col = blk * 64 + wn * 32 + c;
      sp = ni ? src2 : src;
    }
#pragma unroll
    for (int kk = 0; kk < 16; ++kk) {
      int kr = kt * 64 + kq * 16 + kk;
      float v = valid ? sp[(size_t)kr * ld + col] : 0.f;
      sT[(kq * 16 + kk) * 65 + n] = v;
    }
  }
  __syncthreads();
  {
    const int n = tid >> 2, ks = tid & 3;
    unsigned u[8];
#pragma unroll
    for (int e = 0; e < 8; ++e) u[e] = pack2(sT[(ks * 16 + 2 * e) * 65 + n], sT[(ks * 16 + 2 * e + 1) * 65 + n]);
    u4v* d4 = (u4v*)(dst + (size_t)(nt * 64 + n) * K + kt * 64 + ks * 16);
    d4[0] = (u4v){u[0], u[1], u[2], u[3]};
    d4[1] = (u4v){u[4], u[5], u[6], u[7]};
  }
  __syncthreads();
}

#define FILT_ITEMS 576
__device__ __forceinline__ void filt_item(const Params& p, int layer, int item, float* sm) {
  const int half = item >= 512;
  const int pt = half ? item - 512 : item;
  const int L = half ? LS : LP;
  const int RL = 2 * L + 512, OFF = L + 256;
  bf16* rho = half ? p.rhoS : p.rhoP;
  float* sF = sm;
  float* sH1 = sm + 32 * 34;
  float* sH2 = sH1 + 32 * 64;
  const int tid = tid_opaque();
  const float* w1 = p.in[8] + (size_t)layer * 33 * 64;
  const float* b1 = p.in[9] + layer * 64;
  const float* f1 = p.in[10] + layer * 64;
  const float* w2 = p.in[11] + (size_t)layer * 64 * 64;
  const float* b2 = p.in[12] + layer * 64;
  const float* f2 = p.in[13] + layer * 64;
  const float* w3 = p.in[14] + (size_t)layer * 64 * 1024;
  {
    int c0 = half ? pt * 8 : pt, nc = half ? 8 : 1;
    for (int idx = tid; idx < nc * 513; idx += 256) {
      int c = c0 + idx / 513, e = idx % 513;
      int m = e < 257 ? e : (2 * L + 256 + (e - 257));
      rho[(size_t)c * RL + m] = 0;
    }
  }
  for (int idx = tid; idx < 32 * 33; idx += 256) {
    int pl = idx / 33, f = idx % 33;
    int n = pt * 32 + pl;
    float val;
    if (f == 0) val = (float)n / (float)(L - 1);
    else {
      int bi = (f - 1) & 15;
      float fb = 1e-4f + (float)bi * ((15.f - 1e-4f) / 15.f);
      float rev = ((float)n * fb) / (float)L;
      val = (f <= 16) ? cos_rev(rev) : -sin_rev(rev);
    }
    sF[pl * 34 + f] = val;
  }
  __syncthreads();
  {
    const int j = tid & 63, pg = tid >> 6;
    float acc[8];
#pragma unroll
    for (int i = 0; i < 8; ++i) acc[i] = 0.f;
    float wr[33];
#pragma unroll
    for (int f = 0; f < 33; ++f) wr[f] = w1[f * 64 + j];
#pragma unroll
    for (int f = 0; f < 33; ++f) {
#pragma unroll
      for (int i = 0; i < 8; ++i) acc[i] += sF[(pg * 8 + i) * 34 + f] * wr[f];
    }
    float bb = b1[j], ff = f1[j];
#pragma unroll
    for (int i = 0; i < 8; ++i) sH1[(pg * 8 + i) * 64 + j] = sin_rad(ff * (acc[i] + bb));
  }
  __syncthreads();
  {
    const int j = tid & 63, pg = tid >> 6;
    float acc[8];
#pragma unroll
    for (int i = 0; i < 8; ++i) acc[i] = 0.f;
    float wr[64];
#pragma unroll
    for (int f = 0; f < 64; ++f) wr[f] = w2[f * 64 + j];
#pragma unroll
    for (int f = 0; f < 64; ++f) {
#pragma unroll
      for (int i = 0; i < 8; ++i) acc[i] += sH1[(pg * 8 + i) * 64 + f] * wr[f];
    }
    float bb = b2[j], ff = f2[j];
#pragma unroll
    for (int i = 0; i < 8; ++i) sH2[(pg * 8 + i) * 64 + j] = sin_rad(ff * (acc[i] + bb));
  }
  __syncthreads();
  const float dlo = 4.605170185988091f / 1.5f, dhi = 4.605170185988091f / 0.3f;
  {
    bf16* sHb = (bf16*)(sH2 + 32 * 64);
    {
      const int j = tid & 63, pg = tid >> 6;
#pragma unroll
      for (int i = 0; i < 8; ++i) sHb[(pg * 8 + i) * 72 + j] = f2bf(sH2[(pg * 8 + i) * 64 + j]);
    }
    __syncthreads();
    const int lane = tid & 63, w = tid >> 6, r = lane & 31, hh = lane >> 5;
    s8v af[4];
#pragma unroll
    for (int ks = 0; ks < 4; ++ks) af[ks] = *(const s8v*)(sHb + r * 72 + 16 * ks + 8 * hh);
#pragma unroll 2
    for (int n8 = 0; n8 < 8; ++n8) {
      const int c = 32 * (w + 4 * n8) + r;
      f16v acc;
#pragma unroll
      for (int e = 0; e < 16; ++e) acc[e] = 0.f;
#pragma unroll
      for (int ks = 0; ks < 4; ++ks) {
        float wv[8];
#pragma unroll
        for (int e = 0; e < 8; ++e) wv[e] = w3[(16 * ks + 8 * hh + e) * 1024 + c];
        union { s8v v8; unsigned u[4]; } bb;
#pragma unroll
        for (int e = 0; e < 4; ++e) bb.u[e] = pack2(wv[2 * e], wv[2 * e + 1]);
        acc = MFMA(af[ks], bb.v8, acc);
      }
      const int ch = c & 511;
      const float delta = dlo + (dhi - dlo) * ((float)ch / 511.f);
      const float tscale = 1.f / (float)(L - 1);
      float ss = 0.f;
      bf16* rc = rho + (size_t)ch * RL;
#pragma unroll
      for (int e = 0; e < 16; ++e) {
        const int n = pt * 32 + ROW_OF(e, hh);
        const float t = (float)n * tscale;
        const float val = acc[e] * fexp(-t * delta);
        if (c < 512) { rc[OFF - n] = f2bf(val); ss += val * val; }
        else if (n >= 1) { rc[OFF + n] = f2bf(val); ss += val * val; }
      }
      ss += __shfl_xor(ss, 32);
      if (hh == 0) p.sumsq[(size_t)item * 1024 + c] = ss;
    }
  }
  __syncthreads();
}

template <int MI, int NI>
__device__ __forceinline__ void gemm_kloop(const bf16* __restrict__ A, size_t lda, const bf16* __restrict__ Bt, size_t ldb, int K,
                                           f16v (&acc)[MI][NI], bf16* sA, bf16* sB) {
  const int tid = tid_opaque(), lane = tid & 63, w = tid >> 6;
  const int r = lane & 31, hh = lane >> 5;
  const int wm = w >> 1, wn = w & 1;
  const int lrow = tid >> 3, lseg = tid & 7;
  u4v ra[2 * MI], rb[2 * NI];
  const int KT = K >> 6;
#pragma unroll
  for (int i = 0; i < 2 * MI; ++i) ra[i] = *(const u4v*)(A + (size_t)(lrow + 32 * i) * lda + lseg * 8);
#pragma unroll
  for (int i = 0; i < 2 * NI; ++i) rb[i] = *(const u4v*)(Bt + (size_t)(lrow + 32 * i) * ldb + lseg * 8);
  unsigned pfs = 0;
  {
    if (tid < 64 * MI) pfs ^= *(const unsigned*)(A + (size_t)tid * lda + 64) ^ *(const unsigned*)(A + (size_t)tid * lda + 128);
    if (tid < 64 * NI) pfs ^= *(const unsigned*)(Bt + (size_t)tid * ldb + 64) ^ *(const unsigned*)(Bt + (size_t)tid * ldb + 128);
  }
  for (int kt = 0; kt < KT; ++kt) {
    __syncthreads();
#pragma unroll
    for (int i = 0; i < 2 * MI; ++i) *(u4v*)(sA + (lrow + 32 * i) * 72 + lseg * 8) = ra[i];
#pragma unroll
    for (int i = 0; i < 2 * NI; ++i) *(u4v*)(sB + (lrow + 32 * i) * 72 + lseg * 8) = rb[i];
    __syncthreads();
    if (kt + 3 < KT) {
      const int k2 = (kt + 3) << 6;
      if (tid < 64 * MI) pfs ^= *(const unsigned*)(A + (size_t)tid * lda + k2);
      if (tid < 64 * NI) pfs ^= *(const unsigned*)(Bt + (size_t)tid * ldb + k2);
    }
    if (kt + 1 < KT) {
      const int k0 = (kt + 1) << 6;
#pragma unroll
      for (int i = 0; i < 2 * MI; ++i) ra[i] = *(const u4v*)(A + (size_t)(lrow + 32 * i) * lda + k0 + lseg * 8);
#pragma unroll
      for (int i = 0; i < 2 * NI; ++i) rb[i] = *(const u4v*)(Bt + (size_t)(lrow + 32 * i) * ldb + k0 + lseg * 8);
    }
#pragma unroll
    for (int ks = 0; ks < 4; ++ks) {
      s8v a[MI], b[NI];
#pragma unroll
      for (int mi = 0; mi < MI; ++mi) a[mi] = *(const s8v*)(sA + (wm * 32 * MI + mi * 32 + r) * 72 + ks * 16 + hh * 8);
#pragma unroll
      for (int ni = 0; ni < NI; ++ni) b[ni] = *(const s8v*)(sB + (wn * 32 * NI + ni * 32 + r) * 72 + ks * 16 + hh * 8);
#pragma unroll
      for (int mi = 0; mi < MI; ++mi)
#pragma unroll
        for (int ni = 0; ni < NI; ++ni) acc[mi][ni] = MFMA(a[mi], b[ni], acc[mi][ni]);
    }
  }
  if (pfs == 0x9e3779b9u && K == 7) sA[0] = 1;
}

__device__ __forceinline__ void decode_tile(int s, int NT, int MTX, int GM, int xcd, int& mt, int& nt) {
  const int ng = s / (MTX * 16);
  const int s2 = s - ng * MTX * 16;
  const int Hn = min(16, NT - 16 * ng);
  const int pm = s2 / (GM * Hn);
  const int q = s2 - pm * GM * Hn;
  mt = xcd * MTX + pm * GM + (q % GM);
  nt = 16 * ng + q / GM;
}

#define ZERO_ACC(acc, MI_, NI_)                 \
  _Pragma("unroll") for (int mi = 0; mi < MI_; ++mi) \
  _Pragma("unroll") for (int ni = 0; ni < NI_; ++ni) \
  _Pragma("unroll") for (int e = 0; e < 16; ++e) acc[mi][ni][e] = 0.f;


__device__ __forceinline__ void gemm1_tile(const Params& p, int layer, int mt, int nt, bf16* sA, bf16* sB) {
  const int m0 = mt * 256;
  f16v acc[4][2];
  ZERO_ACC(acc, 4, 2)
  gemm_kloop<4, 2>(p.h + (size_t)m0 * DM, DM, p.WinT + (size_t)nt * 128 * DM, DM, DM, acc, sA, sB);
  const int lane = tid_opaque() & 63, w = tid_opaque() >> 6, r = lane & 31, hh = lane >> 5, wm = w >> 1, wn = w & 1;
  if (nt <= 4) {
    const float* g = (nt < 4 ? p.in[4] : p.in[5]) + layer * 64;
    const float g0 = g[r], g1 = g[32 + r];
    const float invf = __builtin_amdgcn_exp2f(-(float)(2 * (r & 15)) * (13.287712379549449f / 32.f)) * 0.15915494309189535f;
    const float osc = nt < 4 ? 0.125f * 1.4426950408889634f : 1.f;
    bf16* dst = nt < 4 ? p.q : p.k;
    const int ldd = nt < 4 ? 512 : 128;
    const int cb = (nt < 4 ? nt * 128 : 0) + wn * 64;
#pragma unroll
    for (int mi = 0; mi < 4; ++mi) {
#pragma unroll
      for (int e = 0; e < 16; ++e) {
        float x1 = acc[mi][0][e], x2 = acc[mi][1][e];
        float ss = x1 * x1 + x2 * x2;
        ss += __shfl_xor(ss, 1); ss += __shfl_xor(ss, 2); ss += __shfl_xor(ss, 4); ss += __shfl_xor(ss, 8); ss += __shfl_xor(ss, 16);
        const float rs = rsqrtf(ss * (1.f / 64.f) + EPSF);
        x1 *= rs * g0; x2 *= rs * g1;
        const int t = m0 + wm * 128 + mi * 32 + ROW_OF(e, hh);
        const int pos = tok_pos(t);
        const float pv = (float)((r < 16) ? (pos >> 6) : (pos & 63));
        const float rev = pv * invf;
        const float cs = cos_rev(rev), sn = sin_rev(rev);
        const float o1 = (x1 * cs - x2 * sn) * osc, o2 = (x1 * sn + x2 * cs) * osc;
        dst[(size_t)t * ldd + cb + r] = f2bf(o1);
        dst[(size_t)t * ldd + cb + 32 + r] = f2bf(o2);
      }
    }
  } else if (nt == 5) {
#pragma unroll
    for (int mi = 0; mi < 4; ++mi)
#pragma unroll
      for (int ni = 0; ni < 2; ++ni)
#pragma unroll
        for (int gq4 = 0; gq4 < 4; ++gq4) {
          const int t = m0 + wm * 128 + mi * 32 + 8 * gq4 + 4 * hh;
          u2v o;
          o.x = pack2(acc[mi][ni][4 * gq4 + 0], acc[mi][ni][4 * gq4 + 1]);
          o.y = pack2(acc[mi][ni][4 * gq4 + 2], acc[mi][ni][4 * gq4 + 3]);
          *(u2v*)(p.vT + (size_t)(wn * 64 + ni * 32 + r) * T_TOK + t) = o;
        }
  } else if (nt < 30) {
    bf16* dst; int ldd, cb;
    if (nt < 10) { dst = p.hv; ldd = 512; cb = (nt - 6) * 128; }
    else if (nt < 14) { dst = p.hx1; ldd = 512; cb = (nt - 10) * 128; }
    else if (nt < 18) { dst = p.hx2; ldd = 512; cb = (nt - 14) * 128; }
    else if (nt < 20) { dst = p.gq; ldd = 256; cb = (nt - 18) * 128; }
    else if (nt < 22) { dst = p.gk; ldd = 256; cb = (nt - 20) * 128; }
    else if (nt < 26) { dst = p.gv; ldd = 512; cb = (nt - 22) * 128; }
    else { dst = p.gog; ldd = 512; cb = (nt - 26) * 128; }
#pragma unroll
    for (int mi = 0; mi < 4; ++mi)
#pragma unroll
      for (int ni = 0; ni < 2; ++ni)
#pragma unroll
        for (int e = 0; e < 16; ++e) {
          const int t = m0 + wm * 128 + mi * 32 + ROW_OF(e, hh);
          dst[(size_t)t * ldd + cb + wn * 64 + ni * 32 + r] = f2bf(acc[mi][ni][e]);
        }
  } else {
    if (wn == 0) {
#pragma unroll
      for (int mi = 0; mi < 4; ++mi)
#pragma unroll
        for (int e = 0; e < 16; ++e) {
          const int t = m0 + wm * 128 + mi * 32 + ROW_OF(e, hh);
          p.glow[(size_t)t * 32 + r] = acc[mi][0][e];
        }
    }
  }
}

__device__ __forceinline__ void merge_tile(const Params& p, int mt, int nt, bf16* sA, bf16* sB) {
  const int m0 = mt * 128, n0 = nt * 128;
  const int lane = tid_opaque() & 63, w = tid_opaque() >> 6, r = lane & 31, hh = lane >> 5, wm = w >> 1, wn = w & 1;
  unsigned mg[2][2][8];
#pragma unroll
  for (int mi = 0; mi < 2; ++mi)
#pragma unroll
    for (int ni = 0; ni < 2; ++ni)
#pragma unroll
      for (int e = 0; e < 8; ++e) mg[mi][ni][e] = 0u;
#pragma unroll 1
  for (int b = 0; b < 3; ++b) {
    unsigned sg[2][2][8];
    {
      f16v ag[2][2];
      ZERO_ACC(ag, 2, 2)
      gemm_kloop<2, 2>(p.h + (size_t)m0 * DM, DM, p.WgT + (size_t)(b * 1024 + n0) * DM, DM, DM, ag, sA, sB);
#pragma unroll
      for (int mi = 0; mi < 2; ++mi)
#pragma unroll
        for (int ni = 0; ni < 2; ++ni)
#pragma unroll
          for (int e = 0; e < 8; ++e) sg[mi][ni][e] = pack2(sigmoidf_(ag[mi][ni][2 * e]), sigmoidf_(ag[mi][ni][2 * e + 1]));
    }
    f16v ap[2][2];
    ZERO_ACC(ap, 2, 2)
    const bf16* ya = b == 0 ? p.q : (b == 1 ? p.hv : p.gog);
    gemm_kloop<2, 2>(ya + (size_t)m0 * 512, 512, p.WbT + (size_t)(b * 1024 + n0) * 512, 512, 512, ap, sA, sB);
#pragma unroll
    for (int mi = 0; mi < 2; ++mi)
#pragma unroll
      for (int ni = 0; ni < 2; ++ni)
#pragma unroll
        for (int e = 0; e < 8; ++e) {
          const float v0 = __uint_as_float(mg[mi][ni][e] << 16) + __uint_as_float(sg[mi][ni][e] << 16) * ap[mi][ni][2 * e];
          const float v1 = __uint_as_float(mg[mi][ni][e] & 0xffff0000u) + __uint_as_float(sg[mi][ni][e] & 0xffff0000u) * ap[mi][ni][2 * e + 1];
          mg[mi][ni][e] = pack2(v0, v1);
        }
  }
#pragma unroll
  for (int mi = 0; mi < 2; ++mi)
#pragma unroll
    for (int ni = 0; ni < 2; ++ni)
#pragma unroll
      for (int e = 0; e < 16; ++e) {
        const int t = m0 + wm * 64 + mi * 32 + ROW_OF(e, hh);
        p.merged[(size_t)t * DM + n0 + wn * 64 + ni * 32 + r] = (bf16)((e & 1) ? (mg[mi][ni][e >> 1] >> 16) : (mg[mi][ni][e >> 1] & 0xffffu));
      }
}

__device__ __forceinline__ void resid_tile(const Params& p, const bf16* A, size_t lda, const bf16* Bt, int K, int mt, int nt, bool x_from_input, bf16* sA, bf16* sB, int dry) {
  const int m0 = mt * 256, n0 = nt * 128;
  f16v acc[4][2];
  ZERO_ACC(acc, 4, 2)
  gemm_kloop<4, 2>(A + (size_t)m0 * lda, lda, Bt + (size_t)n0 * K, K, K, acc, sA, sB);
  const int lane = tid_opaque() & 63, w = tid_opaque() >> 6, r = lane & 31, hh = lane >> 5, wm = w >> 1, wn = w & 1;
#pragma unroll
  for (int mi = 0; mi < 4; ++mi)
#pragma unroll
    for (int ni = 0; ni < 2; ++ni) {
      __builtin_amdgcn_sched_barrier(0);
#pragma unroll
      for (int e = 0; e < 16; ++e) {
        const int t = m0 + wm * 128 + mi * 32 + ROW_OF(e, hh);
        const int c = n0 + wn * 64 + ni * 32 + r;
        const float xo = x_from_input ? (t < LP ? p.in[0][(size_t)t * DM + c] : p.in[1][(size_t)(t - LP) * DM + c]) : p.out[(size_t)t * DM + c];
        if (!dry) p.out[(size_t)t * DM + c] = xo + acc[mi][ni][e];
      }
    }
}

__device__ __forceinline__ void ffn1_tile(const Params& p, int mt, int nt, bf16* sA, bf16* sB) {
  const int m0 = mt * 256;
  f16v acc[4][2];
  ZERO_ACC(acc, 4, 2)
  gemm_kloop<4, 2>(p.h + (size_t)m0 * DM, DM, p.WfguT + (size_t)nt * 128 * DM, DM, DM, acc, sA, sB);
  const int lane = tid_opaque() & 63, w = tid_opaque() >> 6, r = lane & 31, hh = lane >> 5, wm = w >> 1, wn = w & 1;
#pragma unroll
  for (int mi = 0; mi < 4; ++mi)
#pragma unroll
    for (int e = 0; e < 16; ++e) {
      const int t = m0 + wm * 128 + mi * 32 + ROW_OF(e, hh);
      const float v = siluf_(acc[mi][0][e]) * acc[mi][1][e];
      p.act[(size_t)t * 2816 + nt * 64 + wn * 32 + r] = f2bf(v);
    }
}

__device__ __forceinline__ void hy_u_tile(const Params& p, int layer, int item, float* sT) {
  const int ct = item & 7, tt = item >> 3;
  const int t0 = tt * 64, c0 = ct * 64;
  const int tid = tid_opaque();
  const float* cw = p.in[6] + (size_t)layer * 3 * 1536;
  const float* cb = p.in[7] + (size_t)layer * 1536;
  {
    const int cl = tid & 63, tq = tid >> 6;
    const int c = c0 + cl;
    const float wv0 = cw[c], wv1 = cw[1536 + c], wv2 = cw[3072 + c], bv = cb[c];
    const float wx0 = cw[512 + c], wx1 = cw[1536 + 512 + c], wx2 = cw[3072 + 512 + c], bx = cb[512 + c];
    const int ts = t0 + tq * 16;
    const int L = tok_len(ts);
    int pos = tok_pos(ts);
    const int tpv = pos > 0 ? ts - 1 : ts;
    float vp = bf2f(p.hv[(size_t)tpv * 512 + c]);
    float xp = bf2f(p.hx1[(size_t)tpv * 512 + c]);
    vp = pos > 0 ? vp : 0.f;
    xp = pos > 0 ? xp : 0.f;
    float vc = bf2f(p.hv[(size_t)ts * 512 + c]);
    float xc = bf2f(p.hx1[(size_t)ts * 512 + c]);
#pragma unroll
    for (int j = 0; j < 16; ++j) {
      const int t = ts + j;
      const bool hn = (pos + j) < L - 1;
      const int tn = hn ? t + 1 : t;
      float vn = bf2f(p.hv[(size_t)tn * 512 + c]);
      float xn = bf2f(p.hx1[(size_t)tn * 512 + c]);
      vn = hn ? vn : 0.f;
      xn = hn ? xn : 0.f;
      float a = vp * wv0 + vc * wv1 + vn * wv2 + bv;
      float b = xp * wx0 + xc * wx1 + xn * wx2 + bx;
      sT[cl * 65 + tq * 16 + j] = a * b;
      vp = vc; vc = vn; xp = xc; xc = xn;
    }
  }
  __syncthreads();
  {
    const int cl = tid >> 2, sg = tid & 3;
    unsigned u[8];
#pragma unroll
    for (int e = 0; e < 8; ++e) u[e] = pack2(sT[cl * 65 + sg * 16 + 2 * e], sT[cl * 65 + sg * 16 + 2 * e + 1]);
    u4v* d4 = (u4v*)(p.uT + (size_t)(c0 + cl) * T_TOK + t0 + sg * 16);
    d4[0] = (u4v){u[0], u[1], u[2], u[3]};
    d4[1] = (u4v){u[4], u[5], u[6], u[7]};
  }
  __syncthreads();
}

__device__ __forceinline__ void hy_fin_tile(const Params& p, int layer, int item, float* sT) {
  const int ct = item & 7, tt = item >> 3;
  const int t0 = tt * 64, c0 = ct * 64;
  const int tid = tid_opaque();
  const float* cw = p.in[6] + (size_t)layer * 3 * 1536;
  const float* cb = p.in[7] + (size_t)layer * 1536;
  {
    const int cl = tid >> 2, sg = tid & 3;
    const u4v* s4 = (const u4v*)(p.uT + (size_t)(c0 + cl) * T_TOK + t0 + sg * 16);
    u4v a = s4[0], b = s4[1];
    unsigned u[8] = {a.x, a.y, a.z, a.w, b.x, b.y, b.z, b.w};
#pragma unroll
    for (int e = 0; e < 8; ++e) {
      sT[cl * 65 + sg * 16 + 2 * e] = __uint_as_float(u[e] << 16);
      sT[cl * 65 + sg * 16 + 2 * e + 1] = __uint_as_float(u[e] & 0xffff0000u);
    }
  }
  __syncthreads();
  {
    const int cl = tid & 63, tq = tid >> 6;
    const int c = c0 + cl;
    const float w0 = cw[1024 + c], w1 = cw[1536 + 1024 + c], w2 = cw[3072 + 1024 + c], bb = cb[1024 + c];
    const int ts = t0 + tq * 16;
    const int L = tok_len(ts);
    const int pos = tok_pos(ts);
    const int tpv = pos > 0 ? ts - 1 : ts;
    float xp = bf2f(p.hx2[(size_t)tpv * 512 + c]);
    xp = pos > 0 ? xp : 0.f;
    float xc = bf2f(p.hx2[(size_t)ts * 512 + c]);
#pragma unroll
    for (int j = 0; j < 16; ++j) {
      const int t = ts + j;
      const bool hn = (pos + j) < L - 1;
      const int tn = hn ? t + 1 : t;
      float xn = bf2f(p.hx2[(size_t)tn * 512 + c]);
      xn = hn ? xn : 0.f;
      float x2c = xp * w0 + xc * w1 + xn * w2 + bb;
      p.hv[(size_t)t * 512 + c] = f2bf(x2c * sT[cl * 65 + tq * 16 + j]);
      xp = xc; xc = xn;
    }
  }
  __syncthreads();
}

__device__ __forceinline__ void toeplitz_item(const Params& p, int layer, int half, int c, bf16* sm, int dry, unsigned* done_ctr) {
  const int L = half ? LS : LP;
  const int nb = L >> 7;
  const int RL = 2 * L + 512, OFF = L + 256;
  const bf16* rho = (half ? p.rhoS : p.rhoP) + (size_t)c * RL;
  bf16* uT = p.uT + (size_t)c * T_TOK + half * LP;
  bf16* sU = sm;
  bf16* sW = sm + 129 * 136;
  const int tid = tid_opaque(), lane = tid & 63, w = tid >> 6, r = lane & 31, hh = lane >> 5, wm = w >> 1, wn = w & 1;
  float normc;
  {
    const int npt = half ? 64 : 512, pbase = half ? 512 : 0;
    float ssum = 0.f;
    for (int pt = tid; pt < npt; pt += 256) ssum += p.sumsq[(size_t)(pbase + pt) * 1024 + c] + p.sumsq[(size_t)(pbase + pt) * 1024 + 512 + c];
#pragma unroll
    for (int o = 1; o < 64; o <<= 1) ssum += __shfl_xor(ssum, o);
    float* sred = (float*)sm;
    if (lane == 0) sred[w] = ssum;
    __syncthreads();
    normc = rsqrtf(((sred[0] + sred[1]) + (sred[2] + sred[3])) + EPSF);
    __syncthreads();
  }
  for (int i = tid; i < 2048; i += 256) {
    u4v v = *(const u4v*)(uT + i * 8);
    *(u4v*)(sU + (i >> 4) * 136 + (i & 15) * 8) = v;
  }
  if (tid < 17) { unsigned z = 0; asm volatile("" : "+v"(z)); *(u4v*)(sU + 128 * 136 + tid * 8) = (u4v){z, z, z, z}; }
  f16v acc[2][2];
#pragma unroll
  for (int mi = 0; mi < 2; ++mi)
#pragma unroll
    for (int ni = 0; ni < 2; ++ni)
#pragma unroll
      for (int e = 0; e < 16; ++e) acc[mi][ni][e] = 0.f;
  const int nbatch = (2 * nb) >> 2;
  const int aq = (8 - (r & 7)) & 7;
  const int rt = (r + 7) >> 3;
  bf16 wreg[3];
  {
    const int m0 = OFF - 128 * (-nb + 3) - 128;
#pragma unroll
    for (int i = 0; i < 3; ++i) { int x = tid + 256 * i; wreg[i] = x < 648 ? rho[m0 + x] : (bf16)0; }
  }
  for (int bt = 0; bt < nbatch; ++bt) {
    const int D0 = -nb + 4 * bt;
    __syncthreads();
#pragma unroll
    for (int i = 0; i < 3; ++i) {
      const int x = tid + 256 * i;
      if (x < 648) {
#pragma unroll
        for (int qq = 0; qq < 8; ++qq) {
          const int y = x - qq;
          if (y >= 0 && (y >> 3) < 80) sW[(qq * 83 + (y >> 3)) * 8 + (y & 7)] = wreg[i];
        }
      }
    }
    __syncthreads();
    if (bt + 1 < nbatch) {
      const int m0 = OFF - 128 * (D0 + 4 + 3) - 128;
#pragma unroll
      for (int i = 0; i < 3; ++i) { int x = tid + 256 * i; wreg[i] = x < 648 ? rho[m0 + x] : (bf16)0; }
    }
    for (int Dl = 0; Dl < 4; ++Dl) {
      const int D = D0 + Dl;
      bool actv[2];
      int bblk[2];
#pragma unroll
      for (int ni = 0; ni < 2; ++ni) {
        const int nlo = 32 * wn + 64 * ni;
        actv[ni] = half ? true : !((nlo + 31 - D < 0) || (nlo - D >= 128));
        const int n = nlo + r;
        const int src = n - D;
        const bool valid = half ? ((unsigned)((n & 15) - D) < 16u) : ((unsigned)src < 128u);
        bblk[ni] = valid ? src : 128;
      }
      if (!actv[0] && !actv[1]) continue;
      const int tb = 16 * (3 - Dl) + 16 + hh - rt;
      const bf16* ap0 = sW + (aq * 83 + tb - 4 * (2 * wm)) * 8;
      const bf16* bp0 = sU + bblk[0] * 136 + 8 * hh;
      const bf16* bp1 = sU + bblk[1] * 136 + 8 * hh;
      if (actv[0] && actv[1]) {
#pragma unroll
        for (int ks = 0; ks < 8; ++ks) {
          const s8v a0 = *(const s8v*)(ap0 + 16 * ks), a1 = *(const s8v*)(ap0 - 32 + 16 * ks);
          const s8v b0 = *(const s8v*)(bp0 + 16 * ks), b1 = *(const s8v*)(bp1 + 16 * ks);
          acc[0][0] = MFMA(a0, b0, acc[0][0]);
          acc[1][0] = MFMA(a1, b0, acc[1][0]);
          acc[0][1] = MFMA(a0, b1, acc[0][1]);
          acc[1][1] = MFMA(a1, b1, acc[1][1]);
        }
      } else if (actv[0]) {
#pragma unroll
        for (int ks = 0; ks < 8; ++ks) {
          const s8v a0 = *(const s8v*)(ap0 + 16 * ks), a1 = *(const s8v*)(ap0 - 32 + 16 * ks);
          const s8v b0 = *(const s8v*)(bp0 + 16 * ks);
          acc[0][0] = MFMA(a0, b0, acc[0][0]);
          acc[1][0] = MFMA(a1, b0, acc[1][0]);
        }
      } else {
#pragma unroll
        for (int ks = 0; ks < 8; ++ks) {
          const s8v a0 = *(const s8v*)(ap0 + 16 * ks), a1 = *(const s8v*)(ap0 - 32 + 16 * ks);
          const s8v b1 = *(const s8v*)(bp1 + 16 * ks);
          acc[0][1] = MFMA(a0, b1, acc[0][1]);
          acc[1][1] = MFMA(a1, b1, acc[1][1]);
        }
      }
    }
  }
  const float skipc = p.in[15][layer * 512 + c];
#pragma unroll
  for (int mi = 0; mi < 2; ++mi)
#pragma unroll
    for (int ni = 0; ni < 2; ++ni)
#pragma unroll
      for (int g4 = 0; g4 < 4; ++g4) {
        const int ip = 64 * wm + 32 * mi + 8 * g4 + 4 * hh;
        const int I = 32 * wn + 64 * ni + r;
        float v[4];
#pragma unroll
        for (int e = 0; e < 4; ++e) v[e] = normc * acc[mi][ni][4 * g4 + e] + bf2f(sU[I * 136 + ip + e]) * skipc;
        u2v o;
        o.x = pack2(v[0], v[1]);
        o.y = pack2(v[2], v[3]);
        if (!dry) *(u2v*)(uT + 128 * I + ip) = o;
      }
  asm volatile("s_waitcnt vmcnt(0)" ::: "memory");
  __syncthreads();
  if (threadIdx.x == 0 && done_ctr) {
    __builtin_amdgcn_fence(__ATOMIC_RELEASE, "agent");
    asm volatile("s_waitcnt vmcnt(0)" ::: "memory");
    __hip_atomic_fetch_add(done_ctr, 1u, __ATOMIC_RELAXED, __HIP_MEMORY_SCOPE_AGENT);
  }
}

__device__ __forceinline__ void attn_item(const Params& p, int layer, int item, bf16* sm, int dry) {
  int seq, qb, hq;
  if (item < 512) { seq = 0; qb = item >> 3; hq = item & 7; }
  else { int it = item - 512; seq = 1 + (it >> 6); qb = (it & 63) >> 3; hq = it & 7; }
  const int tb = seq == 0 ? 0 : LP + (seq - 1) * LS;
  const int Lk = seq == 0 ? LP : LS;
  const int g = hq >> 2;
  const int tid = tid_opaque(), lane = tid & 63, w = tid >> 6, r = lane & 31, hh = lane >> 5;
  const int tq = tb + qb * 256 + w * 64 + r;
  constexpr int AST = 128 * 72 + 64 * 136;
  bf16* sK = sm;
  bf16* sV = sm + 128 * 72;
  s8v qf[2][4];
#pragma unroll
  for (int qi = 0; qi < 2; ++qi)
#pragma unroll
    for (int ks = 0; ks < 4; ++ks) qf[qi][ks] = *(const s8v*)(p.q + (size_t)(tq + 32 * qi) * 512 + hq * 64 + 16 * ks + 8 * hh);
  f16v O[2][2];
#pragma unroll
  for (int qi = 0; qi < 2; ++qi)
#pragma unroll
    for (int db = 0; db < 2; ++db)
#pragma unroll
      for (int e = 0; e < 16; ++e) O[qi][db][e] = 0.f;
  float l[2] = {0.f, 0.f};
  float negC;
  {
    float gq = fabsf(p.in[4][layer * 64 + lane]), gk = fabsf(p.in[5][layer * 64 + lane]);
#pragma unroll
    for (int o = 1; o < 64; o <<= 1) { gq = fmaxf(gq, __shfl_xor(gq, o)); gk = fmaxf(gk, __shfl_xor(gk, o)); }
    negC = -8.f * gq * gk * 1.4426950408889634f;
  }
  const int lrow = tid >> 2, lseg = tid & 3;
  const bf16* kp = p.k + (size_t)(tb + lrow) * 128 + g * 64 + lseg * 16;
  const bf16* vp = p.vT + (size_t)(g * 64 + lrow) * T_TOK + tb + lseg * 16;
  bf16* wk = sK + lrow * 72 + lseg * 16;
  bf16* wv = sV + lrow * 136 + lseg * 16;
  u4v rk[2], rv[2];
#define AT_LOAD(H64)  { const bf16* kq = kp + (size_t)(H64) * 64 * 128; const bf16* vq = vp + (H64) * 64; \
    rk[0] = *(const u4v*)(kq); rk[1] = *(const u4v*)(kq + 8); rv[0] = *(const u4v*)(vq); rv[1] = *(const u4v*)(vq + 8); }
#define AT_WRITE(ST, H) { bf16* k2 = wk + (ST) * AST + (H) * 64 * 72; bf16* v2 = wv + (ST) * AST + (H) * 64; \
    *(u4v*)(k2) = rk[0]; *(u4v*)(k2 + 8) = rk[1]; *(u4v*)(v2) = rv[0]; *(u4v*)(v2 + 8) = rv[1]; }
  AT_LOAD(0) AT_WRITE(0, 0)
  AT_LOAD(1) AT_WRITE(0, 1)
  __syncthreads();
  const int ntile = Lk >> 7;
  for (int it = 0; it < ntile; ++it) {
    const int cur = it & 1;
    const bool more = it + 1 < ntile;
    if (more) AT_LOAD(2 * it + 2)
#pragma unroll 1
    for (int h = 0; h < 2; ++h) {
      const bf16* cK = sK + cur * AST + h * 64 * 72;
      const bf16* cV = sV + cur * AST + h * 64;
      f16v S[2][2];
#pragma unroll
      for (int kb = 0; kb < 2; ++kb) {
#pragma unroll
        for (int qi = 0; qi < 2; ++qi)
#pragma unroll
          for (int e = 0; e < 16; ++e) S[qi][kb][e] = negC;
#pragma unroll
        for (int ks = 0; ks < 4; ++ks) {
          s8v a = *(const s8v*)(cK + (32 * kb + r) * 72 + 16 * ks + 8 * hh);
#pragma unroll
          for (int qi = 0; qi < 2; ++qi) S[qi][kb] = MFMA(a, qf[qi][ks], S[qi][kb]);
        }
      }
#pragma unroll
      for (int qi = 0; qi < 2; ++qi) {
        float ps = 0.f;
#pragma unroll
        for (int kb = 0; kb < 2; ++kb)
#pragma unroll
          for (int e = 0; e < 16; ++e) { float pv = __builtin_amdgcn_exp2f(S[qi][kb][e]); S[qi][kb][e] = pv; ps += pv; }
        l[qi] += ps;
      }
#pragma unroll
      for (int kb = 0; kb < 2; ++kb)
#pragma unroll
        for (int s2 = 0; s2 < 2; ++s2) {
          s8v bP0 = pack8(S[0][kb], s2);
          s8v bP1 = pack8(S[1][kb], s2);
#pragma unroll
          for (int db = 0; db < 2; ++db) {
            const bf16* vr = cV + (32 * db + r) * 136 + 32 * kb + 16 * s2 + 4 * hh;
            s8v a = ld2x64(vr, vr + 8);
            O[0][db] = MFMA(a, bP0, O[0][db]);
            O[1][db] = MFMA(a, bP1, O[1][db]);
          }
        }
      if (more) {
        AT_WRITE(cur ^ 1, h)
        if (h == 0) AT_LOAD(2 * it + 3)
      }
    }
    __syncthreads();
  }
#undef AT_LOAD
#undef AT_WRITE
  const int tid2 = tid_opaque();
  const int tq2 = tb + qb * 256 + (tid2 >> 6) * 64 + (tid2 & 31);
  const int hh2 = (tid2 >> 5) & 1;
#pragma unroll
  for (int qi = 0; qi < 2; ++qi) {
    const float lt = l[qi] + __shfl_xor(l[qi], 32);
    const float inv = __builtin_amdgcn_rcpf(lt);
#pragma unroll
    for (int db = 0; db < 2; ++db)
#pragma unroll
      for (int g4 = 0; g4 < 4; ++g4) {
        u2v o;
        o.x = pack2(O[qi][db][4 * g4 + 0] * inv, O[qi][db][4 * g4 + 1] * inv);
        o.y = pack2(O[qi][db][4 * g4 + 2] * inv, O[qi][db][4 * g4 + 3] * inv);
        if (!dry) *(u2v*)(p.q + (size_t)(tq2 + 32 * qi) * 512 + hq * 64 + 32 * db + 8 * g4 + 4 * hh2) = o;
      }
  }
}

struct GlaSm {
  bf16 sQ[64 * 72], sK[64 * 72], sQS[64 * 72], sKUT[64 * 72], sVT[128 * 72], sA[64 * 72];
  float sLo[64 * 16], sSeg[4 * 64], sBmid[64], sBtot[64], sDec[64], sRed[4 * 64];
};

template <bool FULL, int DIR>
__device__ __forceinline__ void gla_dir(const Params& p, int layer, int item, GlaSm& sm) {
  const int grp = item >> 2, hd = item & 3;
  constexpr int dir = DIR;
  {
    int tid = tid_opaque(), lane = tid & 63, w = tid >> 6, r = lane & 31, hh = lane >> 5;
    int d = tid & 63, iq = tid >> 6;
    float gu[16];
#pragma unroll
    for (int rr = 0; rr < 16; ++rr) gu[rr] = p.in[16][((size_t)(layer * 2 + dir) * 16 + rr) * 256 + hd * 64 + d];
    const float gb = p.in[17][(layer * 2 + dir) * 256 + hd * 64 + d];
    bf16* gs = p.gstate + ((size_t)(grp * 4 + hd) * 2 + dir) * 8192;
    f16v Sacc[2];
#pragma unroll
    for (int dt = 0; dt < 2; ++dt)
#pragma unroll
      for (int e = 0; e < 16; ++e) Sacc[dt][e] = FULL ? bf2f(gs[(32 * dt + ROW_OF(e, hh)) * 128 + 32 * w + r]) : 0.f;
    float sumtot = 0.f;
    float4 lo_pf;
    {
      const int c0i = dir ? 3 : 0;
      lo_pf = *(const float4*)(p.glow + (size_t)(grp * 256 + c0i * 64 + (tid >> 2)) * 32 + dir * 16 + (tid & 3) * 4);
    }
#pragma unroll 1
    for (int cs = 0; cs < 4; ++cs) {
      const int ci = dir ? 3 - cs : cs;
      const int t0 = grp * 256 + ci * 64;
      tid = tid_opaque(); lane = tid & 63; w = tid >> 6; r = lane & 31; hh = lane >> 5; d = tid & 63; iq = tid >> 6;
      __syncthreads();
      {
        const int tk = tid >> 2, sg = tid & 3;
        *(float4*)(sm.sLo + tk * 16 + sg * 4) = lo_pf;
        if (cs + 1 < 4) {
          const int cn = dir ? 3 - (cs + 1) : cs + 1;
          lo_pf = *(const float4*)(p.glow + (size_t)(grp * 256 + cn * 64 + tk) * 32 + dir * 16 + sg * 4);
        }
      }
      __syncthreads();
      bf16 kr[16], qr[16], vr[32];
#pragma unroll
      for (int j = 0; j < 16; ++j) {
        kr[j] = p.gk[(size_t)(t0 + iq * 16 + j) * 256 + hd * 64 + d];
        qr[j] = FULL ? p.gq[(size_t)(t0 + iq * 16 + j) * 256 + hd * 64 + d] : (bf16)0;
      }
      {
        const int vc = tid & 127, jh = tid >> 7;
#pragma unroll
        for (int j = 0; j < 32; ++j) vr[j] = p.gv[(size_t)(t0 + jh * 32 + j) * 512 + hd * 128 + vc];
      }
      float bv[16];
      float run = 0.f;
#pragma unroll
      for (int jj = 0; jj < 16; ++jj) {
        const int j = dir ? 15 - jj : jj;
        const int i = iq * 16 + j;
        float lg = gb;
#pragma unroll
        for (int rr = 0; rr < 16; ++rr) lg += sm.sLo[i * 16 + rr] * gu[rr];
        const float la = (fminf(lg, 0.f) - __logf(1.f + fexp(-fabsf(lg)))) * (1.f / 16.f);
        run += la;
        bv[j] = run;
      }
      sm.sSeg[iq * 64 + d] = run;
      __syncthreads();
      const float s0 = sm.sSeg[d], s1 = sm.sSeg[64 + d], s2 = sm.sSeg[128 + d], s3 = sm.sSeg[192 + d];
      const float btot = s0 + s1 + s2 + s3;
      float off, bmid;
      if (dir == 0) { off = (iq > 0 ? s0 : 0.f) + (iq > 1 ? s1 : 0.f) + (iq > 2 ? s2 : 0.f); bmid = s0 + s1; }
      else { off = (iq < 3 ? s3 : 0.f) + (iq < 2 ? s2 : 0.f) + (iq < 1 ? s1 : 0.f); bmid = s2 + s3; }
      unsigned ku[8];
#pragma unroll
      for (int j2 = 0; j2 < 8; ++j2) {
        float kuv[2];
#pragma unroll
        for (int e = 0; e < 2; ++e) {
          const int j = 2 * j2 + e;
          const int i = iq * 16 + j;
          const float b = bv[j] + off;
          const float kv = bf2f(kr[j]);
          kuv[e] = kv * fexp(btot - b);
          if (FULL) {
            const float qv = bf2f(qr[j]) * 0.125f;
            sm.sQ[i * 72 + d] = f2bf(qv * fexp(b - bmid));
            sm.sQS[i * 72 + d] = f2bf(qv * fexp(b));
            sm.sK[i * 72 + d] = f2bf(kv * fexp(bmid - b));
          }
        }
        ku[j2] = pack2(kuv[0], kuv[1]);
      }
      *(u4v*)(sm.sKUT + d * 72 + iq * 16) = (u4v){ku[0], ku[1], ku[2], ku[3]};
      *(u4v*)(sm.sKUT + d * 72 + iq * 16 + 8) = (u4v){ku[4], ku[5], ku[6], ku[7]};
      if (iq == 0) { sm.sDec[d] = fexp(btot); sumtot += btot; }
      {
        const int vc = tid & 127, jh = tid >> 7;
        unsigned vu[16];
#pragma unroll
        for (int j2 = 0; j2 < 16; ++j2) {
          vu[j2] = (unsigned)vr[2 * j2] | ((unsigned)vr[2 * j2 + 1] << 16);
        }
#pragma unroll
        for (int q4 = 0; q4 < 4; ++q4)
          *(u4v*)(sm.sVT + vc * 72 + jh * 32 + q4 * 8) = (u4v){vu[4 * q4], vu[4 * q4 + 1], vu[4 * q4 + 2], vu[4 * q4 + 3]};
      }
      __syncthreads();
      f16v o[2];
      if (FULL) {
        const int mi = w >> 1, nj = w & 1;
        f16v aA;
#pragma unroll
        for (int e = 0; e < 16; ++e) aA[e] = 0.f;
#pragma unroll
        for (int ks = 0; ks < 4; ++ks) {
          s8v a = *(const s8v*)(sm.sQ + (32 * mi + r) * 72 + 16 * ks + 8 * hh);
          s8v b = *(const s8v*)(sm.sK + (32 * nj + r) * 72 + 16 * ks + 8 * hh);
          aA = MFMA(a, b, aA);
        }
#pragma unroll
        for (int e = 0; e < 16; ++e) {
          const int i = 32 * mi + ROW_OF(e, hh), j = 32 * nj + r;
          const bool keep = dir ? (j > i) : (j <= i);
          sm.sA[i * 72 + j] = keep ? f2bf(aA[e]) : (bf16)0;
        }
        __syncthreads();
#pragma unroll
        for (int mi2 = 0; mi2 < 2; ++mi2)
#pragma unroll
          for (int e = 0; e < 16; ++e) o[mi2][e] = 0.f;
        __builtin_amdgcn_sched_barrier(0);
#pragma unroll
        for (int ks = 0; ks < 4; ++ks) {
          s8v b = *(const s8v*)(sm.sVT + (32 * w + r) * 72 + 16 * ks + 8 * hh);
#pragma unroll
          for (int mi2 = 0; mi2 < 2; ++mi2) {
            s8v a = *(const s8v*)(sm.sA + (32 * mi2 + r) * 72 + 16 * ks + 8 * hh);
            o[mi2] = MFMA(a, b, o[mi2]);
          }
        }
        __builtin_amdgcn_sched_barrier(0);
#pragma unroll
        for (int dt = 0; dt < 2; ++dt)
#pragma unroll
          for (int s = 0; s < 2; ++s) {
            s8v bS = pack8(Sacc[dt], s);
#pragma unroll
            for (int mi2 = 0; mi2 < 2; ++mi2) {
              const bf16* qr = sm.sQS + (32 * mi2 + r) * 72 + 32 * dt + 16 * s + 4 * hh;
              s8v a = ld2x64(qr, qr + 8);
              o[mi2] = MFMA(a, bS, o[mi2]);
            }
          }
      }
      __builtin_amdgcn_sched_barrier(0);
      if (FULL) {
        const int vcol = hd * 128 + 32 * w + r;
        if (dir == 0) {
#pragma unroll
          for (int mi2 = 0; mi2 < 2; ++mi2)
#pragma unroll
            for (int e = 0; e < 16; ++e) {
              const int i = 32 * mi2 + ROW_OF(e, hh);
              p.of[(size_t)(t0 + i) * 512 + vcol] = f2bf(o[mi2][e]);
            }
        } else {
#pragma unroll
          for (int mi2 = 0; mi2 < 2; ++mi2)
#pragma unroll
            for (int e = 0; e < 16; ++e) {
              const int i = 32 * mi2 + ROW_OF(e, hh);
              const float ot = o[mi2][e] + bf2f(p.of[(size_t)(t0 + i) * 512 + vcol]);
              o[mi2][e] = ot;
              float ss = ot * ot;
              ss += __shfl_xor(ss, 1); ss += __shfl_xor(ss, 2); ss += __shfl_xor(ss, 4); ss += __shfl_xor(ss, 8); ss += __shfl_xor(ss, 16);
              if (r == 0) sm.sRed[w * 64 + i] = ss;
            }
          __syncthreads();
          if (tid < 64) sm.sBmid[tid] = rsqrtf((sm.sRed[tid] + sm.sRed[64 + tid] + sm.sRed[128 + tid] + sm.sRed[192 + tid]) * (1.f / 128.f) + EPSF);
          __syncthreads();
          const float gn = p.in[18][layer * 128 + 32 * w + r];
#pragma unroll
          for (int mi2 = 0; mi2 < 2; ++mi2)
#pragma unroll
            for (int e = 0; e < 16; ++e) {
              const int i = 32 * mi2 + ROW_OF(e, hh);
              const float rs = sm.sBmid[i];
              bf16* og = p.gog + (size_t)(t0 + i) * 512 + vcol;
              *og = f2bf(o[mi2][e] * rs * gn * siluf_(bf2f(*og)));
            }
        }
      }
      __builtin_amdgcn_sched_barrier(0);
      {
        f16v U[2];
#pragma unroll
        for (int dt = 0; dt < 2; ++dt)
#pragma unroll
          for (int e = 0; e < 16; ++e) U[dt][e] = 0.f;
#pragma unroll
        for (int ks = 0; ks < 4; ++ks) {
          s8v b = *(const s8v*)(sm.sVT + (32 * w + r) * 72 + 16 * ks + 8 * hh);
#pragma unroll
          for (int dt = 0; dt < 2; ++dt) {
            s8v a = *(const s8v*)(sm.sKUT + (32 * dt + r) * 72 + 16 * ks + 8 * hh);
            U[dt] = MFMA(a, b, U[dt]);
          }
        }
#pragma unroll
        for (int dt = 0; dt < 2; ++dt)
#pragma unroll
          for (int e = 0; e < 16; ++e) Sacc[dt][e] = sm.sDec[32 * dt + ROW_OF(e, hh)] * Sacc[dt][e] + U[dt][e];
      }
    }
    if (!FULL) {
#pragma unroll
      for (int dt = 0; dt < 2; ++dt)
#pragma unroll
        for (int e = 0; e < 16; ++e) gs[(32 * dt + ROW_OF(e, hh)) * 128 + 32 * w + r] = f2bf(Sacc[dt][e]);
      if (iq == 0) p.gdecay[((size_t)(grp * 4 + hd) * 2 + dir) * 64 + d] = fexp(sumtot);
    }
  }
}
template <bool FULL>
__device__ __forceinline__ void gla_item(const Params& p, int layer, int item, GlaSm& sm) {
  if (FULL) {
    gla_dir<FULL, 0>(p, layer, item, sm);
    gla_dir<FULL, 1>(p, layer, item, sm);
  } else {
    if (item & 1) gla_dir<FULL, 1>(p, layer, item >> 1, sm);
    else gla_dir<FULL, 0>(p, layer, item >> 1, sm);
  }
}

__device__ __forceinline__ void gla_scan_item(const Params& p, int item, int dry, unsigned* done_ctr) {
  const int qq = item & 3, dir = (item >> 2) & 1, hd = (item >> 3) & 3, seq = item >> 5;
  const int ng = seq == 0 ? 64 : 8;
  const int gbase = seq == 0 ? 0 : 64 + 8 * (seq - 1);
  float S[8];
#pragma unroll
  for (int e = 0; e < 8; ++e) S[e] = 0.f;
  const int ib = qq * 2048 + tid_opaque();
#pragma unroll 4
  for (int gi = 0; gi < ng; ++gi) {
    const int g = gbase + (dir ? ng - 1 - gi : gi);
    bf16* gs = p.gstate + ((size_t)(g * 4 + hd) * 2 + dir) * 8192;
    const float* gd = p.gdecay + ((size_t)(g * 4 + hd) * 2 + dir) * 64;
    float u[8], dc[8];
#pragma unroll
    for (int e = 0; e < 8; ++e) { const int idx = ib + 256 * e; u[e] = bf2f(gs[idx]); dc[e] = gd[idx >> 7]; }
#pragma unroll
    for (int e = 0; e < 8; ++e) { const int idx = ib + 256 * e; if (!dry) gs[idx] = f2bf(S[e]); S[e] = dc[e] * S[e] + u[e]; }
  }
  asm volatile("s_waitcnt vmcnt(0)" ::: "memory");
  __syncthreads();
  if (threadIdx.x == 0 && done_ctr) {
    __builtin_amdgcn_fence(__ATOMIC_RELEASE, "agent");
    asm volatile("s_waitcnt vmcnt(0)" ::: "memory");
    __hip_atomic_fetch_add(done_ctr, 1u, __ATOMIC_RELAXED, __HIP_MEMORY_SCOPE_AGENT);
  }
}

#define XB_TMO      128
#define XB_XCNT(j)  (256  + 64 * (j))
#define XB_XSUB(j)  (1280 + 64 * (j))
#define XB_XGEN(j)  (2304 + 64 * (j))
#define XB_TOP      3328
#define XB_TOPGEN   3392
#define XCD_BAR_WORDS 3456
#define XB_SPIN_CAP (1u << 18)
#define LAS __attribute__((address_space(3)))

__device__ __forceinline__ unsigned xb_ld(unsigned* p)              { return __hip_atomic_load(p, __ATOMIC_RELAXED, __HIP_MEMORY_SCOPE_AGENT); }
__device__ __forceinline__ unsigned xb_add(unsigned* p, unsigned v) { return __hip_atomic_fetch_add(p, v, __ATOMIC_RELAXED, __HIP_MEMORY_SCOPE_AGENT); }
__device__ __forceinline__ unsigned xb_xcc_id() { return (unsigned)__builtin_amdgcn_s_getreg((3 << 11) | 20) & 0xFu; }
#define XB_SPIN(cond, bar) do { unsigned _sp = 0; while (cond) { __builtin_amdgcn_s_sleep(1); \
    if ((++_sp & 255u) == 0u) { if (xb_ld(&(bar)[XB_TMO])) break; if (_sp > XB_SPIN_CAP) { atomicAdd(&(bar)[XB_TMO], 1u); break; } } } } while (0)

struct XcdBarrier {
    unsigned* bar; unsigned x;
    volatile LAS unsigned* st;
};

__device__ __forceinline__ XcdBarrier xcd_barrier_post(unsigned* bar, volatile LAS unsigned* st) {
    XcdBarrier b; b.bar = bar; b.x = xb_xcc_id(); b.st = st;
    if (threadIdx.x == 0) (void)xb_add(&bar[XB_XCNT(b.x)], 1u);
    return b;
}
__device__ __forceinline__ void xcd_barrier_complete(unsigned* bar, unsigned x, unsigned& nloc, unsigned& nx) {
    const unsigned G = gridDim.x * gridDim.y * gridDim.z;
    unsigned sum, cnt, mine, sp = 0u;
    for (;;) {
        sum = 0u; cnt = 0u; mine = 0u;
#pragma unroll
        for (unsigned j = 0; j < 16; ++j) { const unsigned c = xb_ld(&bar[XB_XCNT(j)]); sum += c; cnt += (c > 0u) ? 1u : 0u; mine = (j == x) ? c : mine; }
        if (sum == G) break;
        __builtin_amdgcn_s_sleep(1);
        if ((++sp & 255u) == 0u) { if (xb_ld(&bar[XB_TMO])) break; if (sp > XB_SPIN_CAP) { atomicAdd(&bar[XB_TMO], 1u); break; } }
    }
    nloc = mine > 0u ? mine : 1u; nx = cnt > 0u ? cnt : 1u;
}

__device__ __forceinline__ void xcd_barrier(const XcdBarrier& b) {
    asm volatile("s_waitcnt vmcnt(0)" ::: "memory");
    __syncthreads();
    if (threadIdx.x == 0) {
        unsigned* bar = b.bar;
        __builtin_amdgcn_s_waitcnt(0);
        unsigned nloc = b.st[0], nx = b.st[1];
        if (nloc == 0u) { xcd_barrier_complete(bar, b.x, nloc, nx); b.st[0] = nloc; b.st[1] = nx; }
        const unsigned old = xb_add(&bar[XB_XSUB(b.x)], 1u);
        const unsigned gen = old / nloc;
        if (old + 1u == (gen + 1u) * nloc) {
            __builtin_amdgcn_fence(__ATOMIC_RELEASE, "agent");
            asm volatile("s_waitcnt vmcnt(0)" ::: "memory");
            const unsigned og = xb_add(&bar[XB_TOP], 1u);
            const unsigned tg = og / nx;
            if (og + 1u == (tg + 1u) * nx) xb_add(&bar[XB_TOPGEN], 1u);
            else XB_SPIN(xb_ld(&bar[XB_TOPGEN]) == tg, bar);
            __builtin_amdgcn_fence(__ATOMIC_ACQUIRE, "agent");
            xb_add(&bar[XB_XGEN(b.x)], 1u);
            asm volatile("s_waitcnt vmcnt(0)" ::: "memory");
        } else {
            XB_SPIN(xb_ld(&bar[XB_XGEN(b.x)]) == gen, bar);
            __builtin_amdgcn_fence(__ATOMIC_ACQUIRE, "agent");
            asm volatile("s_waitcnt vmcnt(0)" ::: "memory");
        }
    }
    __syncthreads();
}


__device__ __forceinline__ void run_phase(const Params& p, int ph, char* smem, int* s_item, int dup, int dryflag) {
#if PROBE_PHASE >= 0
  const int dry = dup ? dryflag : 0;
#else
  constexpr int dry = 0;
#endif
  if (ph == 4 * NPH_LAYER) { phase_norm(p, p.in[25], false, true); return; }
  const int layer = ph / NPH_LAYER, lp = ph % NPH_LAYER;
  bf16* sA = (bf16*)smem;
  bf16* sB = sA + 256 * 72;
  const int xcd = blockIdx.x & 7, bloc = blockIdx.x >> 3, nloc = gridDim.x >> 3;
  switch (lp) {
    case 0: {
      unsigned* ctr = p.counters + layer * 4 + 3 + dup * 16;
      for (;;) {
        int it = fetch_item(ctr, s_item);
        if (it >= CONV_ITEMS + FILT_ITEMS) break;
        if (it < FILT_ITEMS) { if (!dup || (PROBE_SUB & 1)) filt_item(p, layer, it, (float*)smem); }
        else { if (!dup || (PROBE_SUB & 2)) conv_tile(p, layer, it - FILT_ITEMS, (float*)smem); }
      }
      if (!dup || (PROBE_SUB & 4)) phase_norm(p, p.in[2] + layer * DM, layer == 0, false);
    } break;
    case 1: {
      for (int sq = bloc; sq < 16 * 31; sq += nloc) { int mt, nt; decode_tile(sq, 31, 16, 4, xcd, mt, nt); gemm1_tile(p, layer, mt, nt, sA, sB); }
    } break;
    case 2: {
      unsigned* ctr = p.counters + layer * 4 + 0 + dup * 16;
      for (;;) {
        int it = fetch_item(ctr, s_item);
        if (it >= 1024 + 4096) break;
        if (it < 1024) gla_item<false>(p, layer, it, *(GlaSm*)smem);
        else hy_u_tile(p, layer, it - 1024, (float*)smem);
      }
    } break;
    case 3: {
      unsigned* ctr = p.counters + layer * 4 + 1 + dup * 16;
      bool toep_ok = false;
      for (;;) {
        int it = fetch_item(ctr, s_item);
        if (it >= 2048 + 288 + 512 + 4096) break;
        unsigned* scan_done = p.counters + 48 + layer;
        unsigned* toep_done = p.counters + 52 + layer;
        if (it < 288) { if (!dup || (PROBE_SUB & 4)) gla_scan_item(p, it, dry, dup ? nullptr : scan_done); continue; }
        it -= 288;
        if (it < 512) { if (!dup || (PROBE_SUB & 2)) attn_item(p, layer, it, (bf16*)smem, dry); }
        else if (it < 1024) { if (!dup || (PROBE_SUB & 1)) toeplitz_item(p, layer, 0, it - 512, (bf16*)smem, dry, dup ? nullptr : toep_done); }
        else if (it < 1536) {
          if (!dup) {
            if (threadIdx.x == 0) {
              while (__hip_atomic_load(scan_done, __ATOMIC_RELAXED, __HIP_MEMORY_SCOPE_AGENT) < 288u) __builtin_amdgcn_s_sleep(2);
              __builtin_amdgcn_fence(__ATOMIC_ACQUIRE, "agent");
              asm volatile("s_waitcnt vmcnt(0)" ::: "memory");
            }
            __syncthreads();
            gla_item<true>(p, layer, it - 1024, *(GlaSm*)smem);
          }
        }
        else if (it < 2048) { if (!dup || (PROBE_SUB & 1)) toeplitz_item(p, layer, 1, it - 1536, (bf16*)smem, dry, dup ? nullptr : toep_done); }
        else if (it < 2560) { if (!dup || (PROBE_SUB & 2)) attn_item(p, layer, it - 2048 + 512, (bf16*)smem, dry); }
        else if (!dup) {
          if (!toep_ok) {
            if (threadIdx.x == 0) {
              while (__hip_atomic_load(toep_done, __ATOMIC_RELAXED, __HIP_MEMORY_SCOPE_AGENT) < 1024u) __builtin_amdgcn_s_sleep(2);
              __builtin_amdgcn_fence(__ATOMIC_ACQUIRE, "agent");
              asm volatile("s_waitcnt vmcnt(0)" ::: "memory");
            }
            __syncthreads();
            toep_ok = true;
          }
          hy_fin_tile(p, layer, it - 2560, (float*)smem);
        }
      }
    } break;
    case 4: {
      unsigned* ctr = p.counters + layer * 4 + 2 + dup * 16;
      for (;;) {
        int it = fetch_item(ctr, s_item);
        if (it >= 4096) break;
        hy_fin_tile(p, layer, it, (float*)smem);
      }
    } break;
    case 5: {
      for (int sq = bloc; sq < 32 * 8; sq += nloc) { int mt, nt; decode_tile(sq, 8, 32, 8, xcd, mt, nt); merge_tile(p, mt, nt, sA, sB); }
    } break;
    case 6: {
      for (int sq = bloc; sq < 16 * 8; sq += nloc) { int mt, nt; decode_tile(sq, 8, 16, 4, xcd, mt, nt); resid_tile(p, p.merged, DM, p.WoT, DM, mt, nt, layer == 0, sA, sB, dry); }
    } break;
    case 7: {
      phase_norm(p, p.in[21] + layer * DM, false, false);
    } break;
    case 8: {
      for (int sq = bloc; sq < 16 * 44; sq += nloc) { int mt, nt; decode_tile(sq, 44, 16, 4, xcd, mt, nt); ffn1_tile(p, mt, nt, sA, sB); }
    } break;
    case 9: {
      for (int sq = bloc; sq < 16 * 8; sq += nloc) { int mt, nt; decode_tile(sq, 8, 16, 4, xcd, mt, nt); resid_tile(p, p.act, 2816, p.WfdT, 2816, mt, nt, false, sA, sB, dry); }
    } break;
  }
}

__global__ void __launch_bounds__(256, 2) mk(Params p, int ph_lo, int ph_hi, int coop) {
  __shared__ __attribute__((aligned(16))) char smem[73728];
  __shared__ int s_item;
  __shared__ uint4 xb_words;
  if (threadIdx.x == 0) xb_words = make_uint4(0u, 0u, 0u, 0u);
  __syncthreads();
  XcdBarrier xb = xcd_barrier_post(p.bar, (volatile LAS unsigned*)&xb_words);
  for (int ph = ph_lo; ph < ph_hi; ++ph) {
    if (ph < 4 * NPH_LAYER && (ph % NPH_LAYER) == 4) continue;
#if PROBE_PHASE >= 0
    const int reps = (ph < 4 * NPH_LAYER && (ph % NPH_LAYER) == PROBE_PHASE) ? 2 : 1;
    for (int rep = reps - 1; rep >= 0; --rep) {
      run_phase(p, ph, smem, &s_item, rep, coop);
      if (rep && coop) xcd_barrier(xb);
    }
#else
    run_phase(p, ph, smem, &s_item, 0, 0);
#endif
    if (coop && ph + 1 < ph_hi) {
      if (ph == ph_lo) cg::this_grid().sync();
      else xcd_barrier(xb);
    }
#if PROBE_PHASE == 99
    if (coop) xcd_barrier(xb);
#endif
  }
}

extern "C" void kernel_launch(void* const* d_in, const int* in_sizes, int n_in, void* d_out, int out_size, void* d_ws, size_t ws_size,
                              hipStream_t stream) {
  static int grid = 0;
  if (grid == 0) {
    int dev = 0, cus = 0, per_cu = 0;
    hipGetDevice(&dev);
    hipDeviceGetAttribute(&cus, hipDeviceAttributeMultiprocessorCount, dev);
    hipOccupancyMaxActiveBlocksPerMultiprocessor(&per_cu, mk, 256, 0);
    if (per_cu < 1) per_cu = 1;
    if (per_cu > 2) per_cu = 2;
    grid = cus * per_cu;
  }
  Params p{};
  for (int i = 0; i < 26; ++i) p.in[i] = (const float*)d_in[i];
  p.out = (float*)d_out;
  p.dryflag = 1;
  char* ws = (char*)d_ws;
  size_t off = 0;
  auto take = [&](size_t bytes) { char* r = ws + off; off += (bytes + 255) & ~(size_t)255; return r; };
  const size_t U = (size_t)T_TOK * 512 * 2;
  p.counters = (unsigned*)take(256);
  p.bar = (unsigned*)take((size_t)XCD_BAR_WORDS * 4);
  const size_t zero_bytes = off;
  p.sumsq = (float*)take((size_t)FILT_ITEMS * 1024 * 4);
  p.WinT = (bf16*)take((size_t)3968 * 1024 * 2);
  p.WgT = (bf16*)take((size_t)3072 * 1024 * 2);
  p.WbT = (bf16*)take((size_t)3 * 1024 * 512 * 2);
  p.WoT = (bf16*)take((size_t)1024 * 1024 * 2);
  p.WfguT = (bf16*)take((size_t)5632 * 1024 * 2);
  p.WfdT = (bf16*)take((size_t)1024 * 2816 * 2);
  p.h = (bf16*)take(2 * U);
  p.q = (bf16*)take(U);
  p.k = (bf16*)take(U / 4);
  p.vT = (bf16*)take(U / 4);
  p.hv = (bf16*)take(U);
  p.hx1 = (bf16*)take(U);
  p.hx2 = (bf16*)take(U);
  p.gq = (bf16*)take(U / 2);
  p.gk = (bf16*)take(U / 2);
  p.gv = (bf16*)take(U);
  p.gog = (bf16*)take(U);
  p.act = p.hv;
  p.of = p.hx1;
  p.glow = (float*)take((size_t)T_TOK * 32 * 4);
  p.uT = (bf16*)take(U);
  p.rhoP = (bf16*)take((size_t)512 * (2 * LP + 512) * 2);
  p.merged = p.uT;
  p.rhoS = (bf16*)take((size_t)512 * (2 * LS + 512) * 2);
  p.gstate = (bf16*)take((size_t)128 * 4 * 2 * 8192 * 2);
  p.gdecay = (float*)take((size_t)128 * 4 * 2 * 64 * 4);
  if (off > ws_size) { fprintf(stderr, "kernel_launch: workspace too small: need %zu have %zu\n", off, ws_size); return; }
  hipMemsetAsync(ws, 0, zero_bytes, stream);
  const int nph = 4 * NPH_LAYER + 1;
#if N_LAUNCH_MODE == 1
  int lo = 0, hi = nph, coop = 1;
  void* args[] = {&p, &lo, &hi, &coop};
  hipError_t e = hipLaunchCooperativeKernel((void*)mk, dim3(grid), dim3(256), args, 0, stream);
  if (e != hipSuccess) fprintf(stderr, "cooperative launch failed: %s (grid %d)\n", hipGetErrorString(e), grid);
#else
  for (int ph = 0; ph < nph; ++ph) mk<<<grid, 256, 0, stream>>>(p, ph, ph + 1, 0);
#endif
}
```

```cpp
#include <hip/hip_runtime.h>
#include <hip/hip_cooperative_groups.h>
#include <stdint.h>
#include <stdio.h>
namespace cg = cooperative_groups;

typedef unsigned short bf16;
typedef __attribute__((ext_vector_type(8))) short s8v;
typedef __attribute__((ext_vector_type(4))) short s4v;
typedef __attribute__((ext_vector_type(16))) float f16v;
typedef __attribute__((ext_vector_type(4))) unsigned u4v;
typedef __attribute__((ext_vector_type(2))) unsigned u2v;

#define MFMA(a, b, c) __builtin_amdgcn_mfma_f32_32x32x16_bf16((a), (b), (c), 0, 0, 0)

#define T_TOK 32768
#define LP 16384
#define LS 2048
#define DM 1024
#define EPSF 1e-6f
#define NPH_LAYER 10
#define PROBE_PHASE -1
#define PROBE_SUB 2
#ifndef N_LAUNCH_MODE
#define N_LAUNCH_MODE 1
#endif

struct Params {
  const float* in[26];
  float* out;
  bf16 *WinT, *WgT, *WbT, *WoT, *WfguT, *WfdT;
  bf16 *h, *q, *k, *vT, *hv, *hx1, *hx2, *gq, *gk, *gv, *gog;
  float* glow;
  bf16 *uT, *rhoP, *rhoS;
  bf16* gstate;
  float* gdecay;
  bf16 *of, *merged, *act;
  float* sumsq;
  unsigned* counters;
  unsigned* bar;
  int dryflag, pad_;
};

typedef __bf16 bf2_t __attribute__((ext_vector_type(2)));
typedef float f2_t __attribute__((ext_vector_type(2)));
__device__ __forceinline__ bf16 f2bf(float f) { return __builtin_bit_cast(unsigned short, (__bf16)f); }
__device__ __forceinline__ int tid_opaque() { int t = threadIdx.x; asm volatile("" : "+v"(t)); return t; }
__device__ __forceinline__ float bf2f(bf16 b) { return __uint_as_float(((unsigned)b) << 16); }
__device__ __forceinline__ unsigned pack2(float a, float b) { f2_t f = {a, b}; return __builtin_bit_cast(unsigned, __builtin_convertvector(f, bf2_t)); }
__device__ __forceinline__ float sin_rev(float rev) { rev -= rintf(rev); return __builtin_amdgcn_sinf(rev); }
__device__ __forceinline__ float cos_rev(float rev) { rev -= rintf(rev); return __builtin_amdgcn_cosf(rev); }
__device__ __forceinline__ float sin_rad(float x) { return sin_rev(x * 0.15915494309189535f); }
__device__ __forceinline__ float fexp(float x) { return __builtin_amdgcn_exp2f(x * 1.4426950408889634f); }
__device__ __forceinline__ float sigmoidf_(float x) { return __builtin_amdgcn_rcpf(1.f + fexp(-x)); }
__device__ __forceinline__ float siluf_(float x) { return x * __builtin_amdgcn_rcpf(1.f + fexp(-x)); }
__device__ __forceinline__ int tok_pos(int t) { return t < LP ? t : ((t - LP) & (LS - 1)); }
__device__ __forceinline__ int tok_len(int t) { return t < LP ? LP : LS; }

__device__ __forceinline__ s8v pack8(const f16v& v, int s) {
  union { s8v v8; unsigned u[4]; } r;
  r.u[0] = pack2(v[8 * s + 0], v[8 * s + 1]);
  r.u[1] = pack2(v[8 * s + 2], v[8 * s + 3]);
  r.u[2] = pack2(v[8 * s + 4], v[8 * s + 5]);
  r.u[3] = pack2(v[8 * s + 6], v[8 * s + 7]);
  return r.v8;
}
__device__ __forceinline__ s8v ld2x64(const bf16* p0, const bf16* p1) {
  union { s8v v8; u2v u[2]; } r;
  r.u[0] = *(const u2v*)p0;
  r.u[1] = *(const u2v*)p1;
  return r.v8;
}

__device__ __forceinline__ int fetch_item(unsigned* ctr, int* s_item) {
  __syncthreads();
  if (threadIdx.x == 0) *s_item = (int)atomicAdd(ctr, 1u);
  __syncthreads();
  return *s_item;
}

#define ROW_OF(reg, hh) (((reg) & 3) + 8 * ((reg) >> 2) + 4 * (hh))

__device__ __forceinline__ void phase_norm(const Params& p, const float* g, bool from_input, bool final_out) {
  const int wave = tid_opaque() >> 6, lane = tid_opaque() & 63;
  for (int row0 = (blockIdx.x * 4 + wave) * 2; row0 < T_TOK; row0 += gridDim.x * 8) {
    float4 v[2][4];
    float ss[2] = {0.f, 0.f};
#pragma unroll
    for (int q = 0; q < 2; ++q) {
      const int row = row0 + q;
      const float* xr = from_input ? (row < LP ? p.in[0] + (size_t)row * DM : p.in[1] + (size_t)(row - LP) * DM)
                                   : p.out + (size_t)row * DM;
#pragma unroll
      for (int i = 0; i < 4; ++i) v[q][i] = ((const float4*)xr)[lane + 64 * i];
    }
#pragma unroll
    for (int q = 0; q < 2; ++q) {
#pragma unroll
      for (int i = 0; i < 4; ++i) ss[q] += v[q][i].x * v[q][i].x + v[q][i].y * v[q][i].y + v[q][i].z * v[q][i].z + v[q][i].w * v[q][i].w;
#pragma unroll
      for (int o = 1; o < 64; o <<= 1) ss[q] += __shfl_xor(ss[q], o);
    }
#pragma unroll
    for (int q = 0; q < 2; ++q) {
      const int row = row0 + q;
      const float rs = rsqrtf(ss[q] * (1.f / DM) + EPSF);
#pragma unroll
      for (int i = 0; i < 4; ++i) {
        float4 g4 = ((const float4*)g)[lane + 64 * i];
        float a = v[q][i].x * rs * g4.x, bb = v[q][i].y * rs * g4.y, c = v[q][i].z * rs * g4.z, d = v[q][i].w * rs * g4.w;
        if (final_out) {
          ((float4*)(p.out + (size_t)row * DM))[lane + 64 * i] = make_float4(a, bb, c, d);
        } else {
          u2v o2;
          o2.x = pack2(a, bb);
          o2.y = pack2(c, d);
          *(u2v*)(p.h + (size_t)row * DM + (lane + 64 * i) * 4) = o2;
        }
      }
    }
  }
}

#define CONV_ITEMS 4512
__device__ __forceinline__ void conv_tile(const Params& p, int layer, int item, float* sT) {
  const float* src;
  const float* src2 = nullptr;
  int ld, K, col0 = 0, nvalid, mode = 0, nt, kt;
  bf16* dst;
  if (item < 992) {
    nt = item >> 4; kt = item & 15; src = p.in[3] + (size_t)layer * 1024 * 6944; ld = 6944; K = 1024; nvalid = 3872; dst = p.WinT;
  } else if (item < 1760) {
    int it = item - 992; nt = it >> 4; kt = it & 15; src = p.in[3] + (size_t)layer * 1024 * 6944; ld = 6944; K = 1024; col0 = 3872; nvalid = 3072; dst = p.WgT;
  } else if (item < 2144) {
    int it = item - 1760; int b = it >> 7; it &= 127; nt = it >> 3; kt = it & 7;
    src = p.in[19] + (size_t)(layer * 3 + b) * 512 * 1024; ld = 1024; K = 512; nvalid = 1024; dst = p.WbT + (size_t)b * 1024 * 512;
  } else if (item < 2400) {
    int it = item - 2144; nt = it >> 4; kt = it & 15; src = p.in[20] + (size_t)layer * 1024 * 1024; ld = 1024; K = 1024; nvalid = 1024; dst = p.WoT;
  } else if (item < 3808) {
    int it = item - 2400; nt = it >> 4; kt = it & 15; mode = 1; src = p.in[22] + (size_t)layer * 1024 * 2816; src2 = p.in[23] + (size_t)layer * 1024 * 2816;
    ld = 2816; K = 1024; nvalid = 5632; dst = p.WfguT;
  } else {
    int it = item - 3808; nt = it / 44; kt = it % 44; src = p.in[24] + (size_t)layer * 2816 * 1024; ld = 1024; K = 2816; nvalid = 1024; dst = p.WfdT;
  }
  const int tid = tid_opaque();
  {
    const int n = tid & 63, kq = tid >> 6;
    const int j = nt * 64 + n;
    const float* sp = src;
    int col = col0 + j;
    bool valid = j < nvalid;
    if (mode == 1) {
      int blk = j >> 7, wn = (j >> 6) & 1, ni = (j >> 5) & 1, c = j & 31;
      col = blk * 64 + wn * 32 + c;
      sp = ni ? src2 : src;
    }
#pragma unroll
    for (int kk = 0; kk < 16; ++kk) {
      int kr = kt * 64 + kq * 16 + kk;
      float v = valid ? sp[(size_t)kr * ld + col] : 0.f;
      sT[(kq * 16 + kk) * 65 + n] = v;
    }
  }
  __syncthreads();
  {
    const int n = tid >> 2, ks = tid & 3;
    unsigned u[8];
#pragma unroll
    for (int e = 0; e < 8; ++e) u[e] = pack2(sT[(ks * 16 + 2 * e) * 65 + n], sT[(ks * 16 + 2 * e + 1) * 65 + n]);
    u4v* d4 = (u4v*)(dst + (size_t)(nt * 64 + n) * K + kt * 64 + ks * 16);
    d4[0] = (u4v){u[0], u[1], u[2], u[3]};
    d4[1] = (u4v){u[4], u[5], u[6], u[7]};
  }
  __syncthreads();
}

#define FILT_ITEMS 576
__device__ __forceinline__ void filt_item(const Params& p, int layer, int item, float* sm) {
  const int half = item >= 512;
  const int pt = half ? item - 512 : item;
  const int L = half ? LS : LP;
  const int RL = 2 * L + 512, OFF = L + 256;
  bf16* rho = half ? p.rhoS : p.rhoP;
  float* sF = sm;
  float* sH1 = sm + 32 * 34;
  float* sH2 = sH1 + 32 * 64;
  const int tid = tid_opaque();
  const float* w1 = p.in[8] + (size_t)layer * 33 * 64;
  const float* b1 = p.in[9] + layer * 64;
  const float* f1 = p.in[10] + layer * 64;
  const float* w2 = p.in[11] + (size_t)layer * 64 * 64;
  const float* b2 = p.in[12] + layer * 64;
  const float* f2 = p.in[13] + layer * 64;
  const float* w3 = p.in[14] + (size_t)layer * 64 * 1024;
  {
    int c0 = half ? pt * 8 : pt, nc = half ? 8 : 1;
    for (int idx = tid; idx < nc * 513; idx += 256) {
      int c = c0 + idx / 513, e = idx % 513;
      int m = e < 257 ? e : (2 * L + 256 + (e - 257));
      rho[(size_t)c * RL + m] = 0;
    }
  }
  for (int idx = tid; idx < 32 * 33; idx += 256) {
    int pl = idx / 33, f = idx % 33;
    int n = pt * 32 + pl;
    float val;
    if (f == 0) val = (float)n / (float)(L - 1);
    else {
      int bi = (f - 1) & 15;
      float fb = 1e-4f + (float)bi * ((15.f - 1e-4f) / 15.f);
      float rev = ((float)n * fb) / (float)L;
      val = (f <= 16) ? cos_rev(rev) : -sin_rev(rev);
    }
    sF[pl * 34 + f] = val;
  }
  __syncthreads();
  {
    const int j = tid & 63, pg = tid >> 6;
    float acc[8];
#pragma unroll
    for (int i = 0; i < 8; ++i) acc[i] = 0.f;
    float wr[33];
#pragma unroll
    for (int f = 0; f < 33; ++f) wr[f] = w1[f * 64 + j];
#pragma unroll
    for (int f = 0; f < 33; ++f) {
#pragma unroll
      for (int i = 0; i < 8; ++i) acc[i] += sF[(pg * 8 + i) * 34 + f] * wr[f];
    }
    float bb = b1[j], ff = f1[j];
#pragma unroll
    for (int i = 0; i < 8; ++i) sH1[(pg * 8 + i) * 64 + j] = sin_rad(ff * (acc[i] + bb));
  }
  __syncthreads();
  {
    const int j = tid & 63, pg = tid >> 6;
    float acc[8];
#pragma unroll
    for (int i = 0; i < 8; ++i) acc[i] = 0.f;
    float wr[64];
#pragma unroll
    for (int f = 0; f < 64; ++f) wr[f] = w2[f * 64 + j];
#pragma unroll
    for (int f = 0; f < 64; ++f) {
#pragma unroll
      for (int i = 0; i < 8; ++i) acc[i] += sH1[(pg * 8 + i) * 64 + f] * wr[f];
    }
    float bb = b2[j], ff = f2[j];
#pragma unroll
    for (int i = 0; i < 8; ++i) sH2[(pg * 8 + i) * 64 + j] = sin_rad(ff * (acc[i] + bb));
  }
  __syncthreads();
  const float dlo = 4.605170185988091f / 1.5f, dhi = 4.605170185988091f / 0.3f;
  {
    bf16* sHb = (bf16*)(sH2 + 32 * 64);
    {
      const int j = tid & 63, pg = tid >> 6;
#pragma unroll
      for (int i = 0; i < 8; ++i) sHb[(pg * 8 + i) * 72 + j] = f2bf(sH2[(pg * 8 + i) * 64 + j]);
    }
    __syncthreads();
    const int lane = tid & 63, w = tid >> 6, r = lane & 31, hh = lane >> 5;
    s8v af[4];
#pragma unroll
    for (int ks = 0; ks < 4; ++ks) af[ks] = *(const s8v*)(sHb + r * 72 + 16 * ks + 8 * hh);
#pragma unroll 2
    for (int n8 = 0; n8 < 8; ++n8) {
      const int c = 32 * (w + 4 * n8) + r;
      f16v acc;
#pragma unroll
      for (int e = 0; e < 16; ++e) acc[e] = 0.f;
#pragma unroll
      for (int ks = 0; ks < 4; ++ks) {
        float wv[8];
#pragma unroll
        for (int e = 0; e < 8; ++e) wv[e] = w3[(16 * ks + 8 * hh + e) * 1024 + c];
        union { s8v v8; unsigned u[4]; } bb;
#pragma unroll
        for (int e = 0; e < 4; ++e) bb.u[e] = pack2(wv[2 * e], wv[2 * e + 1]);
        acc = MFMA(af[ks], bb.v8, acc);
      }
      const int ch = c & 511;
      const float delta = dlo + (dhi - dlo) * ((float)ch / 511.f);
      const float tscale = 1.f / (float)(L - 1);
      float ss = 0.f;
      bf16* rc = rho + (size_t)ch * RL;
#pragma unroll
      for (int e = 0; e < 16; ++e) {
        const int n = pt * 32 + ROW_OF(e, hh);
        const float t = (float)n * tscale;
        const float val = acc[e] * fexp(-t * delta);
        if (c < 512) { rc[OFF - n] = f2bf(val); ss += val * val; }
        else if (n >= 1) { rc[OFF + n] = f2bf(val); ss += val * val; }
      }
      ss += __shfl_xor(ss, 32);
      if (hh == 0) p.sumsq[(size_t)item * 1024 + c] = ss;
    }
  }
  __syncthreads();
}

template <int MI, int NI>
__device__ __forceinline__ void gemm_kloop(const bf16* __restrict__ A, size_t lda, const bf16* __restrict__ Bt, size_t ldb, int K,
                                           f16v (&acc)[MI][NI], bf16* sA, bf16* sB) {
  const int tid = tid_opaque(), lane = tid & 63, w = tid >> 6;
  const int r = lane & 31, hh = lane >> 5;
  const int wm = w >> 1, wn = w & 1;
  const int lrow = tid >> 3, lseg = tid & 7;
  u4v ra[2 * MI], rb[2 * NI];
  const int KT = K >> 6;
#pragma unroll
  for (int i = 0; i < 2 * MI; ++i) ra[i] = *(const u4v*)(A + (size_t)(lrow + 32 * i) * lda + lseg * 8);
#pragma unroll
  for (int i = 0; i < 2 * NI; ++i) rb[i] = *(const u4v*)(Bt + (size_t)(lrow + 32 * i) * ldb + lseg * 8);
  unsigned pfs = 0;
  {
    if (tid < 64 * MI) pfs ^= *(const unsigned*)(A + (size_t)tid * lda + 64) ^ *(const unsigned*)(A + (size_t)tid * lda + 128);
    if (tid < 64 * NI) pfs ^= *(const unsigned*)(Bt + (size_t)tid * ldb + 64) ^ *(const unsigned*)(Bt + (size_t)tid * ldb + 128);
  }
  for (int kt = 0; kt < KT; ++kt) {
    __syncthreads();
#pragma unroll
    for (int i = 0; i < 2 * MI; ++i) *(u4v*)(sA + (lrow + 32 * i) * 72 + lseg * 8) = ra[i];
#pragma unroll
    for (int i = 0; i < 2 * NI; ++i) *(u4v*)(sB + (lrow + 32 * i) * 72 + lseg * 8) = rb[i];
    __syncthreads();
    if (kt + 3 < KT) {
      const int k2 = (kt + 3) << 6;
      if (tid < 64 * MI) pfs ^= *(const unsigned*)(A + (size_t)tid * lda + k2);
      if (tid < 64 * NI) pfs ^= *(const unsigned*)(Bt + (size_t)tid * ldb + k2);
    }
    if (kt + 1 < KT) {
      const int k0 = (kt + 1) << 6;
#pragma unroll
      for (int i = 0; i < 2 * MI; ++i) ra[i] = *(const u4v*)(A + (size_t)(lrow + 32 * i) * lda + k0 + lseg * 8);
#pragma unroll
      for (int i = 0; i < 2 * NI; ++i) rb[i] = *(const u4v*)(Bt + (size_t)(lrow + 32 * i) * ldb + k0 + lseg * 8);
    }
#pragma unroll
    for (int ks = 0; ks < 4; ++ks) {
      s8v a[MI], b[NI];
#pragma unroll
      for (int mi = 0; mi < MI; ++mi) a[mi] = *(const s8v*)(sA + (wm * 32 * MI + mi * 32 + r) * 72 + ks * 16 + hh * 8);
#pragma unroll
      for (int ni = 0; ni < NI; ++ni) b[ni] = *(const s8v*)(sB + (wn * 32 * NI + ni * 32 + r) * 72 + ks * 16 + hh * 8);
#pragma unroll
      for (int mi = 0; mi < MI; ++mi)
#pragma unroll
        for (int ni = 0; ni < NI; ++ni) acc[mi][ni] = MFMA(a[mi], b[ni], acc[mi][ni]);
    }
  }
  if (pfs == 0x9e3779b9u && K == 7) sA[0] = 1;
}

__device__ __forceinline__ void decode_tile(int s, int NT, int MTX, int GM, int xcd, int& mt, int& nt) {
  const int ng = s / (MTX * 16);
  const int s2 = s - ng * MTX * 16;
  const int Hn = min(16, NT - 16 * ng);
  const int pm = s2 / (GM * Hn);
  const int q = s2 - pm * GM * Hn;
  mt = xcd * MTX + pm * GM + (q % GM);
  nt = 16 * ng + q / GM;
}

#define ZERO_ACC(acc, MI_, NI_)                 \
  _Pragma("unroll") for (int mi = 0; mi < MI_; ++mi) \
  _Pragma("unroll") for (int ni = 0; ni < NI_; ++ni) \
  _Pragma("unroll") for (int e = 0; e < 16; ++e) acc[mi][ni][e] = 0.f;


__device__ __forceinline__ void gemm1_tile(const Params& p, int layer, int mt, int nt, bf16* sA, bf16* sB) {
  const int m0 = mt * 256;
  f16v acc[4][2];
  ZERO_ACC(acc, 4, 2)
  gemm_kloop<4, 2>(p.h + (size_t)m0 * DM, DM, p.WinT + (size_t)nt * 128 * DM, DM, DM, acc, sA, sB);
  const int lane = tid_opaque() & 63, w = tid_opaque() >> 6, r = lane & 31, hh = lane >> 5, wm = w >> 1, wn = w & 1;
  if (nt <= 4) {
    const float* g = (nt < 4 ? p.in[4] : p.in[5]) + layer * 64;
    const float g0 = g[r], g1 = g[32 + r];
    const float invf = __builtin_amdgcn_exp2f(-(float)(2 * (r & 15)) * (13.287712379549449f / 32.f)) * 0.15915494309189535f;
    const float osc = nt < 4 ? 0.125f * 1.4426950408889634f : 1.f;
    bf16* dst = nt < 4 ? p.q : p.k;
    const int ldd = nt < 4 ? 512 : 128;
    const int cb = (nt < 4 ? nt * 128 : 0) + wn * 64;
#pragma unroll
    for (int mi = 0; mi < 4; ++mi) {
#pragma unroll
      for (int e = 0; e < 16; ++e) {
        float x1 = acc[mi][0][e], x2 = acc[mi][1][e];
        float ss = x1 * x1 + x2 * x2;
        ss += __shfl_xor(ss, 1); ss += __shfl_xor(ss, 2); ss += __shfl_xor(ss, 4); ss += __shfl_xor(ss, 8); ss += __shfl_xor(ss, 16);
        const float rs = rsqrtf(ss * (1.f / 64.f) + EPSF);
        x1 *= rs * g0; x2 *= rs * g1;
        const int t = m0 + wm * 128 + mi * 32 + ROW_OF(e, hh);
        const int pos = tok_pos(t);
        const float pv = (float)((r < 16) ? (pos >> 6) : (pos & 63));
        const float rev = pv * invf;
        const float cs = cos_rev(rev), sn = sin_rev(rev);
        const float o1 = (x1 * cs - x2 * sn) * osc, o2 = (x1 * sn + x2 * cs) * osc;
        dst[(size_t)t * ldd + cb + r] = f2bf(o1);
        dst[(size_t)t * ldd + cb + 32 + r] = f2bf(o2);
      }
    }
  } else if (nt == 5) {
#pragma unroll
    for (int mi = 0; mi < 4; ++mi)
#pragma unroll
      for (int ni = 0; ni < 2; ++ni)
#pragma unroll
        for (int gq4 = 0; gq4 < 4; ++gq4) {
          const int t = m0 + wm * 128 + mi * 32 + 8 * gq4 + 4 * hh;
          u2v o;
          o.x = pack2(acc[mi][ni][4 * gq4 + 0], acc[mi][ni][4 * gq4 + 1]);
          o.y = pack2(acc[mi][ni][4 * gq4 + 2], acc[mi][ni][4 * gq4 + 3]);
          *(u2v*)(p.vT + (size_t)(wn * 64 + ni * 32 + r) * T_TOK + t) = o;
        }
  } else if (nt < 30) {
    bf16* dst; int ldd, cb;
    if (nt < 10) { dst = p.hv; ldd = 512; cb = (nt - 6) * 128; }
    else if (nt < 14) { dst = p.hx1; ldd = 512; cb = (nt - 10) * 128; }
    else if (nt < 18) { dst = p.hx2; ldd = 512; cb = (nt - 14) * 128; }
    else if (nt < 20) { dst = p.gq; ldd = 256; cb = (nt - 18) * 128; }
    else if (nt < 22) { dst = p.gk; ldd = 256; cb = (nt - 20) * 128; }
    else if (nt < 26) { dst = p.gv; ldd = 512; cb = (nt - 22) * 128; }
    else { dst = p.gog; ldd = 512; cb = (nt - 26) * 128; }
#pragma unroll
    for (int mi = 0; mi < 4; ++mi)
#pragma unroll
      for (int ni = 0; ni < 2; ++ni)
#pragma unroll
        for (int e = 0; e < 16; ++e) {
          const int t = m0 + wm * 128 + mi * 32 + ROW_OF(e, hh);
          dst[(size_t)t * ldd + cb + wn * 64 + ni * 32 + r] = f2bf(acc[mi][ni][e]);
        }
  } else {
    if (wn == 0) {
#pragma unroll
      for (int mi = 0; mi < 4; ++mi)
#pragma unroll
        for (int e = 0; e < 16; ++e) {
          const int t = m0 + wm * 128 + mi * 32 + ROW_OF(e, hh);
          p.glow[(size_t)t * 32 + r] = acc[mi][0][e];
        }
    }
  }
}

__device__ __forceinline__ void merge_tile(const Params& p, int mt, int nt, bf16* sA, bf16* sB) {
  const int m0 = mt * 128, n0 = nt * 128;
  const int lane = tid_opaque() & 63, w = tid_opaque() >> 6, r = lane & 31, hh = lane >> 5, wm = w >> 1, wn = w & 1;
  unsigned mg[2][2][8];
#pragma unroll
  for (int mi = 0; mi < 2; ++mi)
#pragma unroll
    for (int ni = 0; ni < 2; ++ni)
#pragma unroll
      for (int e = 0; e < 8; ++e) mg[mi][ni][e] = 0u;
#pragma unroll 1
  for (int b = 0; b < 3; ++b) {
    unsigned sg[2][2][8];
    {
      f16v ag[2][2];
      ZERO_ACC(ag, 2, 2)
      gemm_kloop<2, 2>(p.h + (size_t)m0 * DM, DM, p.WgT + (size_t)(b * 1024 + n0) * DM, DM, DM, ag, sA, sB);
#pragma unroll
      for (int mi = 0; mi < 2; ++mi)
#pragma unroll
        for (int ni = 0; ni < 2; ++ni)
#pragma unroll
          for (int e = 0; e < 8; ++e) sg[mi][ni][e] = pack2(sigmoidf_(ag[mi][ni][2 * e]), sigmoidf_(ag[mi][ni][2 * e + 1]));
    }
    f16v ap[2][2];
    ZERO_ACC(ap, 2, 2)
    const bf16* ya = b == 0 ? p.q : (b == 1 ? p.hv : p.gog);
    gemm_kloop<2, 2>(ya + (size_t)m0 * 512, 512, p.WbT + (size_t)(b * 1024 + n0) * 512, 512, 512, ap, sA, sB);
#pragma unroll
    for (int mi = 0; mi < 2; ++mi)
#pragma unroll
      for (int ni = 0; ni < 2; ++ni)
#pragma unroll
        for (int e = 0; e < 8; ++e) {
          const float v0 = __uint_as_float(mg[mi][ni][e] << 16) + __uint_as_float(sg[mi][ni][e] << 16) * ap[mi][ni][2 * e];
          const float v1 = __uint_as_float(mg[mi][ni][e] & 0xffff0000u) + __uint_as_float(sg[mi][ni][e] & 0xffff0000u) * ap[mi][ni][2 * e + 1];
          mg[mi][ni][e] = pack2(v0, v1);
        }
  }
#pragma unroll
  for (int mi = 0; mi < 2; ++mi)
#pragma unroll
    for (int ni = 0; ni < 2; ++ni)
#pragma unroll
      for (int e = 0; e < 16; ++e) {
        const int t = m0 + wm * 64 + mi * 32 + ROW_OF(e, hh);
        p.merged[(size_t)t * DM + n0 + wn * 64 + ni * 32 + r] = (bf16)((e & 1) ? (mg[mi][ni][e >> 1] >> 16) : (mg[mi][ni][e >> 1] & 0xffffu));
      }
}

__device__ __forceinline__ void resid_tile(const Params& p, const bf16* A, size_t lda, const bf16* Bt, int K, int mt, int nt, bool x_from_input, bf16* sA, bf16* sB, int dry) {
  const int m0 = mt * 256, n0 = nt * 128;
  f16v acc[4][2];
  ZERO_ACC(acc, 4, 2)
  gemm_kloop<4, 2>(A + (size_t)m0 * lda, lda, Bt + (size_t)n0 * K, K, K, acc, sA, sB);
  const int lane = tid_opaque() & 63, w = tid_opaque() >> 6, r = lane & 31, hh = lane >> 5, wm = w >> 1, wn = w & 1;
#pragma unroll
  for (int mi = 0; mi < 4; ++mi)
#pragma unroll
    for (int ni = 0; ni < 2; ++ni) {
      __builtin_amdgcn_sched_barrier(0);
#pragma unroll
      for (int e = 0; e < 16; ++e) {
        const int t = m0 + wm * 128 + mi * 32 + ROW_OF(e, hh);
        const int c = n0 + wn * 64 + ni * 32 + r;
        const float xo = x_from_input ? (t < LP ? p.in[0][(size_t)t * DM + c] : p.in[1][(size_t)(t - LP) * DM + c]) : p.out[(size_t)t * DM + c];
        if (!dry) p.out[(size_t)t * DM + c] = xo + acc[mi][ni][e];
      }
    }
}

__device__ __forceinline__ void ffn1_tile(const Params& p, int mt, int nt, bf16* sA, bf16* sB) {
  const int m0 = mt * 256;
  f16v acc[4][2];
  ZERO_ACC(acc, 4, 2)
  gemm_kloop<4, 2>(p.h + (size_t)m0 * DM, DM, p.WfguT + (size_t)nt * 128 * DM, DM, DM, acc, sA, sB);
  const int lane = tid_opaque() & 63, w = tid_opaque() >> 6, r = lane & 31, hh = lane >> 5, wm = w >> 1, wn = w & 1;
#pragma unroll
  for (int mi = 0; mi < 4; ++mi)
#pragma unroll
    for (int e = 0; e < 16; ++e) {
      const int t = m0 + wm * 128 + mi * 32 + ROW_OF(e, hh);
      const float v = siluf_(acc[mi][0][e]) * acc[mi][1][e];
      p.act[(size_t)t * 2816 + nt * 64 + wn * 32 + r] = f2bf(v);
    }
}

__device__ __forceinline__ void hy_u_tile(const Params& p, int layer, int item, float* sT) {
  const int ct = item & 7, tt = item >> 3;
  const int t0 = tt * 64, c0 = ct * 64;
  const int tid = tid_opaque();
  const float* cw = p.in[6] + (size_t)layer * 3 * 1536;
  const float* cb = p.in[7] + (size_t)layer * 1536;
  {
    const int cl = tid & 63, tq = tid >> 6;
    const int c = c0 + cl;
    const float wv0 = cw[c], wv1 = cw[1536 + c], wv2 = cw[3072 + c], bv = cb[c];
    const float wx0 = cw[512 + c], wx1 = cw[1536 + 512 + c], wx2 = cw[3072 + 512 + c], bx = cb[512 + c];
    const int ts = t0 + tq * 16;
    const int L = tok_len(ts);
    int pos = tok_pos(ts);
    const int tpv = pos > 0 ? ts - 1 : ts;
    float vp = bf2f(p.hv[(size_t)tpv * 512 + c]);
    float xp = bf2f(p.hx1[(size_t)tpv * 512 + c]);
    vp = pos > 0 ? vp : 0.f;
    xp = pos > 0 ? xp : 0.f;
    float vc = bf2f(p.hv[(size_t)ts * 512 + c]);
    float xc = bf2f(p.hx1[(size_t)ts * 512 + c]);
#pragma unroll
    for (int j = 0; j < 16; ++j) {
      const int t = ts + j;
      const bool hn = (pos + j) < L - 1;
      const int tn = hn ? t + 1 : t;
      float vn = bf2f(p.hv[(size_t)tn * 512 + c]);
      float xn = bf2f(p.hx1[(size_t)tn * 512 + c]);
      vn = hn ? vn : 0.f;
      xn = hn ? xn : 0.f;
      float a = vp * wv0 + vc * wv1 + vn * wv2 + bv;
      float b = xp * wx0 + xc * wx1 + xn * wx2 + bx;
      sT[cl * 65 + tq * 16 + j] = a * b;
      vp = vc; vc = vn; xp = xc; xc = xn;
    }
  }
  __syncthreads();
  {
    const int cl = tid >> 2, sg = tid & 3;
    unsigned u[8];
#pragma unroll
    for (int e = 0; e < 8; ++e) u[e] = pack2(sT[cl * 65 + sg * 16 + 2 * e], sT[cl * 65 + sg * 16 + 2 * e + 1]);
    u4v* d4 = (u4v*)(p.uT + (size_t)(c0 + cl) * T_TOK + t0 + sg * 16);
    d4[0] = (u4v){u[0], u[1], u[2], u[3]};
    d4[1] = (u4v){u[4], u[5], u[6], u[7]};
  }
  __syncthreads();
}

__device__ __forceinline__ void hy_fin_tile(const Params& p, int layer, int item, float* sT) {
  const int ct = item & 7, tt = item >> 3;
  const int t0 = tt * 64, c0 = ct * 64;
  const int tid = tid_opaque();
  const float* cw = p.in[6] + (size_t)layer * 3 * 1536;
  const float* cb = p.in[7] + (size_t)layer * 1536;
  {
    const int cl = tid >> 2, sg = tid & 3;
    const u4v* s4 = (const u4v*)(p.uT + (size_t)(c0 + cl) * T_TOK + t0 + sg * 16);
    u4v a = s4[0], b = s4[1];
    unsigned u[8] = {a.x, a.y, a.z, a.w, b.x, b.y, b.z, b.w};
#pragma unroll
    for (int e = 0; e < 8; ++e) {
      sT[cl * 65 + sg * 16 + 2 * e] = __uint_as_float(u[e] << 16);
      sT[cl * 65 + sg * 16 + 2 * e + 1] = __uint_as_float(u[e] & 0xffff0000u);
    }
  }
  __syncthreads();
  {
    const int cl = tid & 63, tq = tid >> 6;
    const int c = c0 + cl;
    const float w0 = cw[1024 + c], w1 = cw[1536 + 1024 + c], w2 = cw[3072 + 1024 + c], bb = cb[1024 + c];
    const int ts = t0 + tq * 16;
    const int L = tok_len(ts);
    const int pos = tok_pos(ts);
    const int tpv = pos > 0 ? ts - 1 : ts;
    float xp = bf2f(p.hx2[(size_t)tpv * 512 + c]);
    xp = pos > 0 ? xp : 0.f;
    float xc = bf2f(p.hx2[(size_t)ts * 512 + c]);
#pragma unroll
    for (int j = 0; j < 16; ++j) {
      const int t = ts + j;
      const bool hn = (pos + j) < L - 1;
      const int tn = hn ? t + 1 : t;
      float xn = bf2f(p.hx2[(size_t)tn * 512 + c]);
      xn = hn ? xn : 0.f;
      float x2c = xp * w0 + xc * w1 + xn * w2 + bb;
      p.hv[(size_t)t * 512 + c] = f2bf(x2c * sT[cl * 65 + tq * 16 + j]);
      xp = xc; xc = xn;
    }
  }
  __syncthreads();
}

__device__ __forceinline__ void toeplitz_item(const Params& p, int layer, int half, int c, bf16* sm, int dry) {
  const int L = half ? LS : LP;
  const int nb = L >> 7;
  const int RL = 2 * L + 512, OFF = L + 256;
  const bf16* rho = (half ? p.rhoS : p.rhoP) + (size_t)c * RL;
  bf16* uT = p.uT + (size_t)c * T_TOK + half * LP;
  bf16* sU = sm;
  bf16* sW = sm + 129 * 136;
  const int tid = tid_opaque(), lane = tid & 63, w = tid >> 6, r = lane & 31, hh = lane >> 5, wm = w >> 1, wn = w & 1;
  float normc;
  {
    const int npt = half ? 64 : 512, pbase = half ? 512 : 0;
    float ssum = 0.f;
    for (int pt = tid; pt < npt; pt += 256) ssum += p.sumsq[(size_t)(pbase + pt) * 1024 + c] + p.sumsq[(size_t)(pbase + pt) * 1024 + 512 + c];
#pragma unroll
    for (int o = 1; o < 64; o <<= 1) ssum += __shfl_xor(ssum, o);
    float* sred = (float*)sm;
    if (lane == 0) sred[w] = ssum;
    __syncthreads();
    normc = rsqrtf(((sred[0] + sred[1]) + (sred[2] + sred[3])) + EPSF);
    __syncthreads();
  }
  for (int i = tid; i < 2048; i += 256) {
    u4v v = *(const u4v*)(uT + i * 8);
    *(u4v*)(sU + (i >> 4) * 136 + (i & 15) * 8) = v;
  }
  if (tid < 17) { unsigned z = 0; asm volatile("" : "+v"(z)); *(u4v*)(sU + 128 * 136 + tid * 8) = (u4v){z, z, z, z}; }
  f16v acc[2][2];
#pragma unroll
  for (int mi = 0; mi < 2; ++mi)
#pragma unroll
    for (int ni = 0; ni < 2; ++ni)
#pragma unroll
      for (int e = 0; e < 16; ++e) acc[mi][ni][e] = 0.f;
  const int nbatch = (2 * nb) >> 2;
  const int aq = (8 - (r & 7)) & 7;
  const int rt = (r + 7) >> 3;
  bf16 wreg[3];
  {
    const int m0 = OFF - 128 * (-nb + 3) - 128;
#pragma unroll
    for (int i = 0; i < 3; ++i) { int x = tid + 256 * i; wreg[i] = x < 648 ? rho[m0 + x] : (bf16)0; }
  }
  for (int bt = 0; bt < nbatch; ++bt) {
    const int D0 = -nb + 4 * bt;
    __syncthreads();
#pragma unroll
    for (int i = 0; i < 3; ++i) {
      const int x = tid + 256 * i;
      if (x < 648) {
#pragma unroll
        for (int qq = 0; qq < 8; ++qq) {
          const int y = x - qq;
          if (y >= 0 && (y >> 3) < 80) sW[(qq * 83 + (y >> 3)) * 8 + (y & 7)] = wreg[i];
        }
      }
    }
    __syncthreads();
    if (bt + 1 < nbatch) {
      const int m0 = OFF - 128 * (D0 + 4 + 3) - 128;
#pragma unroll
      for (int i = 0; i < 3; ++i) { int x = tid + 256 * i; wreg[i] = x < 648 ? rho[m0 + x] : (bf16)0; }
    }
    for (int Dl = 0; Dl < 4; ++Dl) {
      const int D = D0 + Dl;
      bool actv[2];
      int bblk[2];
#pragma unroll
      for (int ni = 0; ni < 2; ++ni) {
        const int nlo = 32 * wn + 64 * ni;
        actv[ni] = half ? true : !((nlo + 31 - D < 0) || (nlo - D >= 128));
        const int n = nlo + r;
        const int src = n - D;
        const bool valid = half ? ((unsigned)((n & 15) - D) < 16u) : ((unsigned)src < 128u);
        bblk[ni] = valid ? src : 128;
      }
      if (!actv[0] && !actv[1]) continue;
      const int tb = 16 * (3 - Dl) + 16 + hh - rt;
      const bf16* ap0 = sW + (aq * 83 + tb - 4 * (2 * wm)) * 8;
      const bf16* bp0 = sU + bblk[0] * 136 + 8 * hh;
      const bf16* bp1 = sU + bblk[1] * 136 + 8 * hh;
      if (actv[0] && actv[1]) {
#pragma unroll
        for (int ks = 0; ks < 8; ++ks) {
          const s8v a0 = *(const s8v*)(ap0 + 16 * ks), a1 = *(const s8v*)(ap0 - 32 + 16 * ks);
          const s8v b0 = *(const s8v*)(bp0 + 16 * ks), b1 = *(const s8v*)(bp1 + 16 * ks);
          acc[0][0] = MFMA(a0, b0, acc[0][0]);
          acc[1][0] = MFMA(a1, b0, acc[1][0]);
          acc[0][1] = MFMA(a0, b1, acc[0][1]);
          acc[1][1] = MFMA(a1, b1, acc[1][1]);
        }
      } else if (actv[0]) {
#pragma unroll
        for (int ks = 0; ks < 8; ++ks) {
          const s8v a0 = *(const s8v*)(ap0 + 16 * ks), a1 = *(const s8v*)(ap0 - 32 + 16 * ks);
          const s8v b0 = *(const s8v*)(bp0 + 16 * ks);
          acc[0][0] = MFMA(a0, b0, acc[0][0]);
          acc[1][0] = MFMA(a1, b0, acc[1][0]);
        }
      } else {
#pragma unroll
        for (int ks = 0; ks < 8; ++ks) {
          const s8v a0 = *(const s8v*)(ap0 + 16 * ks), a1 = *(const s8v*)(ap0 - 32 + 16 * ks);
          const s8v b1 = *(const s8v*)(bp1 + 16 * ks);
          acc[0][1] = MFMA(a0, b1, acc[0][1]);
          acc[1][1] = MFMA(a1, b1, acc[1][1]);
        }
      }
    }
  }
  const float skipc = p.in[15][layer * 512 + c];
#pragma unroll
  for (int mi = 0; mi < 2; ++mi)
#pragma unroll
    for (int ni = 0; ni < 2; ++ni)
#pragma unroll
      for (int g4 = 0; g4 < 4; ++g4) {
        const int ip = 64 * wm + 32 * mi + 8 * g4 + 4 * hh;
        const int I = 32 * wn + 64 * ni + r;
        float v[4];
#pragma unroll
        for (int e = 0; e < 4; ++e) v[e] = normc * acc[mi][ni][4 * g4 + e] + bf2f(sU[I * 136 + ip + e]) * skipc;
        u2v o;
        o.x = pack2(v[0], v[1]);
        o.y = pack2(v[2], v[3]);
        if (!dry) *(u2v*)(uT + 128 * I + ip) = o;
      }
}

__device__ __forceinline__ void attn_item(const Params& p, int layer, int item, bf16* sm, int dry) {
  int seq, qb, hq;
  if (item < 512) { seq = 0; qb = item >> 3; hq = item & 7; }
  else { int it = item - 512; seq = 1 + (it >> 6); qb = (it & 63) >> 3; hq = it & 7; }
  const int tb = seq == 0 ? 0 : LP + (seq - 1) * LS;
  const int Lk = seq == 0 ? LP : LS;
  const int g = hq >> 2;
  const int tid = tid_opaque(), lane = tid & 63, w = tid >> 6, r = lane & 31, hh = lane >> 5;
  const int tq = tb + qb * 256 + w * 64 + r;
  constexpr int AST = 128 * 72 + 64 * 136;
  bf16* sK = sm;
  bf16* sV = sm + 128 * 72;
  s8v qf[2][4];
#pragma unroll
  for (int qi = 0; qi < 2; ++qi)
#pragma unroll
    for (int ks = 0; ks < 4; ++ks) qf[qi][ks] = *(const s8v*)(p.q + (size_t)(tq + 32 * qi) * 512 + hq * 64 + 16 * ks + 8 * hh);
  f16v O[2][2];
#pragma unroll
  for (int qi = 0; qi < 2; ++qi)
#pragma unroll
    for (int db = 0; db < 2; ++db)
#pragma unroll
      for (int e = 0; e < 16; ++e) O[qi][db][e] = 0.f;
  float l[2] = {0.f, 0.f};
  float negC;
  {
    float gq = fabsf(p.in[4][layer * 64 + lane]), gk = fabsf(p.in[5][layer * 64 + lane]);
#pragma unroll
    for (int o = 1; o < 64; o <<= 1) { gq = fmaxf(gq, __shfl_xor(gq, o)); gk = fmaxf(gk, __shfl_xor(gk, o)); }
    negC = -8.f * gq * gk * 1.4426950408889634f;
  }
  const int lrow = tid >> 2, lseg = tid & 3;
  const bf16* kp = p.k + (size_t)(tb + lrow) * 128 + g * 64 + lseg * 16;
  const bf16* vp = p.vT + (size_t)(g * 64 + lrow) * T_TOK + tb + lseg * 16;
  bf16* wk = sK + lrow * 72 + lseg * 16;
  bf16* wv = sV + lrow * 136 + lseg * 16;
  u4v rk[2], rv[2];
#define AT_LOAD(H64)  { const bf16* kq = kp + (size_t)(H64) * 64 * 128; const bf16* vq = vp + (H64) * 64; \
    rk[0] = *(const u4v*)(kq); rk[1] = *(const u4v*)(kq + 8); rv[0] = *(const u4v*)(vq); rv[1] = *(const u4v*)(vq + 8); }
#define AT_WRITE(ST, H) { bf16* k2 = wk + (ST) * AST + (H) * 64 * 72; bf16* v2 = wv + (ST) * AST + (H) * 64; \
    *(u4v*)(k2) = rk[0]; *(u4v*)(k2 + 8) = rk[1]; *(u4v*)(v2) = rv[0]; *(u4v*)(v2 + 8) = rv[1]; }
  AT_LOAD(0) AT_WRITE(0, 0)
  AT_LOAD(1) AT_WRITE(0, 1)
  __syncthreads();
  const int ntile = Lk >> 7;
  for (int it = 0; it < ntile; ++it) {
    const int cur = it & 1;
    const bool more = it + 1 < ntile;
    if (more) AT_LOAD(2 * it + 2)
#pragma unroll 1
    for (int h = 0; h < 2; ++h) {
      const bf16* cK = sK + cur * AST + h * 64 * 72;
      const bf16* cV = sV + cur * AST + h * 64;
      f16v S[2][2];
#pragma unroll
      for (int kb = 0; kb < 2; ++kb) {
#pragma unroll
        for (int qi = 0; qi < 2; ++qi)
#pragma unroll
          for (int e = 0; e < 16; ++e) S[qi][kb][e] = negC;
#pragma unroll
        for (int ks = 0; ks < 4; ++ks) {
          s8v a = *(const s8v*)(cK + (32 * kb + r) * 72 + 16 * ks + 8 * hh);
#pragma unroll
          for (int qi = 0; qi < 2; ++qi) S[qi][kb] = MFMA(a, qf[qi][ks], S[qi][kb]);
        }
      }
#pragma unroll
      for (int qi = 0; qi < 2; ++qi) {
        float ps = 0.f;
#pragma unroll
        for (int kb = 0; kb < 2; ++kb)
#pragma unroll
          for (int e = 0; e < 16; ++e) { float pv = __builtin_amdgcn_exp2f(S[qi][kb][e]); S[qi][kb][e] = pv; ps += pv; }
        l[qi] += ps;
      }
#pragma unroll
      for (int kb = 0; kb < 2; ++kb)
#pragma unroll
        for (int s2 = 0; s2 < 2; ++s2) {
          s8v bP0 = pack8(S[0][kb], s2);
          s8v bP1 = pack8(S[1][kb], s2);
#pragma unroll
          for (int db = 0; db < 2; ++db) {
            const bf16* vr = cV + (32 * db + r) * 136 + 32 * kb + 16 * s2 + 4 * hh;
            s8v a = ld2x64(vr, vr + 8);
            O[0][db] = MFMA(a, bP0, O[0][db]);
            O[1][db] = MFMA(a, bP1, O[1][db]);
          }
        }
      if (more) {
        AT_WRITE(cur ^ 1, h)
        if (h == 0) AT_LOAD(2 * it + 3)
      }
    }
    __syncthreads();
  }
#undef AT_LOAD
#undef AT_WRITE
  const int tid2 = tid_opaque();
  const int tq2 = tb + qb * 256 + (tid2 >> 6) * 64 + (tid2 & 31);
  const int hh2 = (tid2 >> 5) & 1;
#pragma unroll
  for (int qi = 0; qi < 2; ++qi) {
    const float lt = l[qi] + __shfl_xor(l[qi], 32);
    const float inv = __builtin_amdgcn_rcpf(lt);
#pragma unroll
    for (int db = 0; db < 2; ++db)
#pragma unroll
      for (int g4 = 0; g4 < 4; ++g4) {
        u2v o;
        o.x = pack2(O[qi][db][4 * g4 + 0] * inv, O[qi][db][4 * g4 + 1] * inv);
        o.y = pack2(O[qi][db][4 * g4 + 2] * inv, O[qi][db][4 * g4 + 3] * inv);
        if (!dry) *(u2v*)(p.q + (size_t)(tq2 + 32 * qi) * 512 + hq * 64 + 32 * db + 8 * g4 + 4 * hh2) = o;
      }
  }
}

struct GlaSm {
  bf16 sQ[64 * 72], sK[64 * 72], sQS[64 * 72], sKUT[64 * 72], sVT[128 * 72], sA[64 * 72];
  float sLo[64 * 16], sSeg[4 * 64], sBmid[64], sBtot[64], sDec[64], sRed[4 * 64];
};

template <bool FULL, int DIR>
__device__ __forceinline__ void gla_dir(const Params& p, int layer, int item, GlaSm& sm) {
  const int grp = item >> 2, hd = item & 3;
  constexpr int dir = DIR;
  {
    int tid = tid_opaque(), lane = tid & 63, w = tid >> 6, r = lane & 31, hh = lane >> 5;
    int d = tid & 63, iq = tid >> 6;
    float gu[16];
#pragma unroll
    for (int rr = 0; rr < 16; ++rr) gu[rr] = p.in[16][((size_t)(layer * 2 + dir) * 16 + rr) * 256 + hd * 64 + d];
    const float gb = p.in[17][(layer * 2 + dir) * 256 + hd * 64 + d];
    bf16* gs = p.gstate + ((size_t)(grp * 4 + hd) * 2 + dir) * 8192;
    f16v Sacc[2];
#pragma unroll
    for (int dt = 0; dt < 2; ++dt)
#pragma unroll
      for (int e = 0; e < 16; ++e) Sacc[dt][e] = FULL ? bf2f(gs[(32 * dt + ROW_OF(e, hh)) * 128 + 32 * w + r]) : 0.f;
    float sumtot = 0.f;
    float4 lo_pf;
    {
      const int c0i = dir ? 3 : 0;
      lo_pf = *(const float4*)(p.glow + (size_t)(grp * 256 + c0i * 64 + (tid >> 2)) * 32 + dir * 16 + (tid & 3) * 4);
    }
#pragma unroll 1
    for (int cs = 0; cs < 4; ++cs) {
      const int ci = dir ? 3 - cs : cs;
      const int t0 = grp * 256 + ci * 64;
      tid = tid_opaque(); lane = tid & 63; w = tid >> 6; r = lane & 31; hh = lane >> 5; d = tid & 63; iq = tid >> 6;
      __syncthreads();
      {
        const int tk = tid >> 2, sg = tid & 3;
        *(float4*)(sm.sLo + tk * 16 + sg * 4) = lo_pf;
        if (cs + 1 < 4) {
          const int cn = dir ? 3 - (cs + 1) : cs + 1;
          lo_pf = *(const float4*)(p.glow + (size_t)(grp * 256 + cn * 64 + tk) * 32 + dir * 16 + sg * 4);
        }
      }
      __syncthreads();
      bf16 kr[16], qr[16], vr[32];
#pragma unroll
      for (int j = 0; j < 16; ++j) {
        kr[j] = p.gk[(size_t)(t0 + iq * 16 + j) * 256 + hd * 64 + d];
        qr[j] = FULL ? p.gq[(size_t)(t0 + iq * 16 + j) * 256 + hd * 64 + d] : (bf16)0;
      }
      {
        const int vc = tid & 127, jh = tid >> 7;
#pragma unroll
        for (int j = 0; j < 32; ++j) vr[j] = p.gv[(size_t)(t0 + jh * 32 + j) * 512 + hd * 128 + vc];
      }
      float bv[16];
      float run = 0.f;
#pragma unroll
      for (int jj = 0; jj < 16; ++jj) {
        const int j = dir ? 15 - jj : jj;
        const int i = iq * 16 + j;
        float lg = gb;
#pragma unroll
        for (int rr = 0; rr < 16; ++rr) lg += sm.sLo[i * 16 + rr] * gu[rr];
        const float la = (fminf(lg, 0.f) - __logf(1.f + fexp(-fabsf(lg)))) * (1.f / 16.f);
        run += la;
        bv[j] = run;
      }
      sm.sSeg[iq * 64 + d] = run;
      __syncthreads();
      const float s0 = sm.sSeg[d], s1 = sm.sSeg[64 + d], s2 = sm.sSeg[128 + d], s3 = sm.sSeg[192 + d];
      const float btot = s0 + s1 + s2 + s3;
      float off, bmid;
      if (dir == 0) { off = (iq > 0 ? s0 : 0.f) + (iq > 1 ? s1 : 0.f) + (iq > 2 ? s2 : 0.f); bmid = s0 + s1; }
      else { off = (iq < 3 ? s3 : 0.f) + (iq < 2 ? s2 : 0.f) + (iq < 1 ? s1 : 0.f); bmid = s2 + s3; }
      unsigned ku[8];
#pragma unroll
      for (int j2 = 0; j2 < 8; ++j2) {
        float kuv[2];
#pragma unroll
        for (int e = 0; e < 2; ++e) {
          const int j = 2 * j2 + e;
          const int i = iq * 16 + j;
          const float b = bv[j] + off;
          const float kv = bf2f(kr[j]);
          kuv[e] = kv * fexp(btot - b);
          if (FULL) {
            const float qv = bf2f(qr[j]) * 0.125f;
            sm.sQ[i * 72 + d] = f2bf(qv * fexp(b - bmid));
            sm.sQS[i * 72 + d] = f2bf(qv * fexp(b));
            sm.sK[i * 72 + d] = f2bf(kv * fexp(bmid - b));
          }
        }
        ku[j2] = pack2(kuv[0], kuv[1]);
      }
      *(u4v*)(sm.sKUT + d * 72 + iq * 16) = (u4v){ku[0], ku[1], ku[2], ku[3]};
      *(u4v*)(sm.sKUT + d * 72 + iq * 16 + 8) = (u4v){ku[4], ku[5], ku[6], ku[7]};
      if (iq == 0) { sm.sDec[d] = fexp(btot); sumtot += btot; }
      {
        const int vc = tid & 127, jh = tid >> 7;
        unsigned vu[16];
#pragma unroll
        for (int j2 = 0; j2 < 16; ++j2) {
          vu[j2] = (unsigned)vr[2 * j2] | ((unsigned)vr[2 * j2 + 1] << 16);
        }
#pragma unroll
        for (int q4 = 0; q4 < 4; ++q4)
          *(u4v*)(sm.sVT + vc * 72 + jh * 32 + q4 * 8) = (u4v){vu[4 * q4], vu[4 * q4 + 1], vu[4 * q4 + 2], vu[4 * q4 + 3]};
      }
      __syncthreads();
      f16v o[2];
      if (FULL) {
        const int mi = w >> 1, nj = w & 1;
        f16v aA;
#pragma unroll
        for (int e = 0; e < 16; ++e) aA[e] = 0.f;
#pragma unroll
        for (int ks = 0; ks < 4; ++ks) {
          s8v a = *(const s8v*)(sm.sQ + (32 * mi + r) * 72 + 16 * ks + 8 * hh);
          s8v b = *(const s8v*)(sm.sK + (32 * nj + r) * 72 + 16 * ks + 8 * hh);
          aA = MFMA(a, b, aA);
        }
#pragma unroll
        for (int e = 0; e < 16; ++e) {
          const int i = 32 * mi + ROW_OF(e, hh), j = 32 * nj + r;
          const bool keep = dir ? (j > i) : (j <= i);
          sm.sA[i * 72 + j] = keep ? f2bf(aA[e]) : (bf16)0;
        }
        __syncthreads();
#pragma unroll
        for (int mi2 = 0; mi2 < 2; ++mi2)
#pragma unroll
          for (int e = 0; e < 16; ++e) o[mi2][e] = 0.f;
        __builtin_amdgcn_sched_barrier(0);
#pragma unroll
        for (int ks = 0; ks < 4; ++ks) {
          s8v b = *(const s8v*)(sm.sVT + (32 * w + r) * 72 + 16 * ks + 8 * hh);
#pragma unroll
          for (int mi2 = 0; mi2 < 2; ++mi2) {
            s8v a = *(const s8v*)(sm.sA + (32 * mi2 + r) * 72 + 16 * ks + 8 * hh);
            o[mi2] = MFMA(a, b, o[mi2]);
          }
        }
        __builtin_amdgcn_sched_barrier(0);
#pragma unroll
        for (int dt = 0; dt < 2; ++dt)
#pragma unroll
          for (int s = 0; s < 2; ++s) {
            s8v bS = pack8(Sacc[dt], s);
#pragma unroll
            for (int mi2 = 0; mi2 < 2; ++mi2) {
              const bf16* qr = sm.sQS + (32 * mi2 + r) * 72 + 32 * dt + 16 * s + 4 * hh;
              s8v a = ld2x64(qr, qr + 8);
              o[mi2] = MFMA(a, bS, o[mi2]);
            }
          }
      }
      __builtin_amdgcn_sched_barrier(0);
      if (FULL) {
        const int vcol = hd * 128 + 32 * w + r;
        if (dir == 0) {
#pragma unroll
          for (int mi2 = 0; mi2 < 2; ++mi2)
#pragma unroll
            for (int e = 0; e < 16; ++e) {
              const int i = 32 * mi2 + ROW_OF(e, hh);
              p.of[(size_t)(t0 + i) * 512 + vcol] = f2bf(o[mi2][e]);
            }
        } else {
#pragma unroll
          for (int mi2 = 0; mi2 < 2; ++mi2)
#pragma unroll
            for (int e = 0; e < 16; ++e) {
              const int i = 32 * mi2 + ROW_OF(e, hh);
              const float ot = o[mi2][e] + bf2f(p.of[(size_t)(t0 + i) * 512 + vcol]);
              o[mi2][e] = ot;
              float ss = ot * ot;
              ss += __shfl_xor(ss, 1); ss += __shfl_xor(ss, 2); ss += __shfl_xor(ss, 4); ss += __shfl_xor(ss, 8); ss += __shfl_xor(ss, 16);
              if (r == 0) sm.sRed[w * 64 + i] = ss;
            }
          __syncthreads();
          if (tid < 64) sm.sBmid[tid] = rsqrtf((sm.sRed[tid] + sm.sRed[64 + tid] + sm.sRed[128 + tid] + sm.sRed[192 + tid]) * (1.f / 128.f) + EPSF);
          __syncthreads();
          const float gn = p.in[18][layer * 128 + 32 * w + r];
#pragma unroll
          for (int mi2 = 0; mi2 < 2; ++mi2)
#pragma unroll
            for (int e = 0; e < 16; ++e) {
              const int i = 32 * mi2 + ROW_OF(e, hh);
              const float rs = sm.sBmid[i];
              bf16* og = p.gog + (size_t)(t0 + i) * 512 + vcol;
              *og = f2bf(o[mi2][e] * rs * gn * siluf_(bf2f(*og)));
            }
        }
      }
      __builtin_amdgcn_sched_barrier(0);
      {
        f16v U[2];
#pragma unroll
        for (int dt = 0; dt < 2; ++dt)
#pragma unroll
          for (int e = 0; e < 16; ++e) U[dt][e] = 0.f;
#pragma unroll
        for (int ks = 0; ks < 4; ++ks) {
          s8v b = *(const s8v*)(sm.sVT + (32 * w + r) * 72 + 16 * ks + 8 * hh);
#pragma unroll
          for (int dt = 0; dt < 2; ++dt) {
            s8v a = *(const s8v*)(sm.sKUT + (32 * dt + r) * 72 + 16 * ks + 8 * hh);
            U[dt] = MFMA(a, b, U[dt]);
          }
        }
#pragma unroll
        for (int dt = 0; dt < 2; ++dt)
#pragma unroll
          for (int e = 0; e < 16; ++e) Sacc[dt][e] = sm.sDec[32 * dt + ROW_OF(e, hh)] * Sacc[dt][e] + U[dt][e];
      }
    }
    if (!FULL) {
#pragma unroll
      for (int dt = 0; dt < 2; ++dt)
#pragma unroll
        for (int e = 0; e < 16; ++e) gs[(32 * dt + ROW_OF(e, hh)) * 128 + 32 * w + r] = f2bf(Sacc[dt][e]);
      if (iq == 0) p.gdecay[((size_t)(grp * 4 + hd) * 2 + dir) * 64 + d] = fexp(sumtot);
    }
  }
}
template <bool FULL>
__device__ __forceinline__ void gla_item(const Params& p, int layer, int item, GlaSm& sm) {
  if (FULL) {
    gla_dir<FULL, 0>(p, layer, item, sm);
    gla_dir<FULL, 1>(p, layer, item, sm);
  } else {
    if (item & 1) gla_dir<FULL, 1>(p, layer, item >> 1, sm);
    else gla_dir<FULL, 0>(p, layer, item >> 1, sm);
  }
}

__device__ __forceinline__ void gla_scan_item(const Params& p, int item, int dry, unsigned* done_ctr) {
  const int qq = item & 3, dir = (item >> 2) & 1, hd = (item >> 3) & 3, seq = item >> 5;
  const int ng = seq == 0 ? 64 : 8;
  const int gbase = seq == 0 ? 0 : 64 + 8 * (seq - 1);
  float S[8];
#pragma unroll
  for (int e = 0; e < 8; ++e) S[e] = 0.f;
  const int ib = qq * 2048 + tid_opaque();
#pragma unroll 4
  for (int gi = 0; gi < ng; ++gi) {
    const int g = gbase + (dir ? ng - 1 - gi : gi);
    bf16* gs = p.gstate + ((size_t)(g * 4 + hd) * 2 + dir) * 8192;
    const float* gd = p.gdecay + ((size_t)(g * 4 + hd) * 2 + dir) * 64;
    float u[8], dc[8];
#pragma unroll
    for (int e = 0; e < 8; ++e) { const int idx = ib + 256 * e; u[e] = bf2f(gs[idx]); dc[e] = gd[idx >> 7]; }
#pragma unroll
    for (int e = 0; e < 8; ++e) { const int idx = ib + 256 * e; if (!dry) gs[idx] = f2bf(S[e]); S[e] = dc[e] * S[e] + u[e]; }
  }
  asm volatile("s_waitcnt vmcnt(0)" ::: "memory");
  __syncthreads();
  if (threadIdx.x == 0 && done_ctr) {
    __builtin_amdgcn_fence(__ATOMIC_RELEASE, "agent");
    asm volatile("s_waitcnt vmcnt(0)" ::: "memory");
    __hip_atomic_fetch_add(done_ctr, 1u, __ATOMIC_RELAXED, __HIP_MEMORY_SCOPE_AGENT);
  }
}

#define XB_TMO      128
#define XB_XCNT(j)  (256  + 64 * (j))
#define XB_XSUB(j)  (1280 + 64 * (j))
#define XB_XGEN(j)  (2304 + 64 * (j))
#define XB_TOP      3328
#define XB_TOPGEN   3392
#define XCD_BAR_WORDS 3456
#define XB_SPIN_CAP (1u << 18)
#define LAS __attribute__((address_space(3)))

__device__ __forceinline__ unsigned xb_ld(unsigned* p)              { return __hip_atomic_load(p, __ATOMIC_RELAXED, __HIP_MEMORY_SCOPE_AGENT); }
__device__ __forceinline__ unsigned xb_add(unsigned* p, unsigned v) { return __hip_atomic_fetch_add(p, v, __ATOMIC_RELAXED, __HIP_MEMORY_SCOPE_AGENT); }
__device__ __forceinline__ unsigned xb_xcc_id() { return (unsigned)__builtin_amdgcn_s_getreg((3 << 11) | 20) & 0xFu; }
#define XB_SPIN(cond, bar) do { unsigned _sp = 0; while (cond) { __builtin_amdgcn_s_sleep(1); \
    if ((++_sp & 255u) == 0u) { if (xb_ld(&(bar)[XB_TMO])) break; if (_sp > XB_SPIN_CAP) { atomicAdd(&(bar)[XB_TMO], 1u); break; } } } } while (0)

struct XcdBarrier {
    unsigned* bar; unsigned x;
    volatile LAS unsigned* st;
};

__device__ __forceinline__ XcdBarrier xcd_barrier_post(unsigned* bar, volatile LAS unsigned* st) {
    XcdBarrier b; b.bar = bar; b.x = xb_xcc_id(); b.st = st;
    if (threadIdx.x == 0) (void)xb_add(&bar[XB_XCNT(b.x)], 1u);
    return b;
}
__device__ __forceinline__ void xcd_barrier_complete(unsigned* bar, unsigned x, unsigned& nloc, unsigned& nx) {
    const unsigned G = gridDim.x * gridDim.y * gridDim.z;
    unsigned sum, cnt, mine, sp = 0u;
    for (;;) {
        sum = 0u; cnt = 0u; mine = 0u;
#pragma unroll
        for (unsigned j = 0; j < 16; ++j) { const unsigned c = xb_ld(&bar[XB_XCNT(j)]); sum += c; cnt += (c > 0u) ? 1u : 0u; mine = (j == x) ? c : mine; }
        if (sum == G) break;
        __builtin_amdgcn_s_sleep(1);
        if ((++sp & 255u) == 0u) { if (xb_ld(&bar[XB_TMO])) break; if (sp > XB_SPIN_CAP) { atomicAdd(&bar[XB_TMO], 1u); break; } }
    }
    nloc = mine > 0u ? mine : 1u; nx = cnt > 0u ? cnt : 1u;
}

__device__ __forceinline__ void xcd_barrier(const XcdBarrier& b) {
    asm volatile("s_waitcnt vmcnt(0)" ::: "memory");
    __syncthreads();
    if (threadIdx.x == 0) {
        unsigned* bar = b.bar;
        __builtin_amdgcn_s_waitcnt(0);
        unsigned nloc = b.st[0], nx = b.st[1];
        if (nloc == 0u) { xcd_barrier_complete(bar, b.x, nloc, nx); b.st[0] = nloc; b.st[1] = nx; }
        const unsigned old = xb_add(&bar[XB_XSUB(b.x)], 1u);
        const unsigned gen = old / nloc;
        if (old + 1u == (gen + 1u) * nloc) {
            __builtin_amdgcn_fence(__ATOMIC_RELEASE, "agent");
            asm volatile("s_waitcnt vmcnt(0)" ::: "memory");
            const unsigned og = xb_add(&bar[XB_TOP], 1u);
            const unsigned tg = og / nx;
            if (og + 1u == (tg + 1u) * nx) xb_add(&bar[XB_TOPGEN], 1u);
            else XB_SPIN(xb_ld(&bar[XB_TOPGEN]) == tg, bar);
            __builtin_amdgcn_fence(__ATOMIC_ACQUIRE, "agent");
            xb_add(&bar[XB_XGEN(b.x)], 1u);
            asm volatile("s_waitcnt vmcnt(0)" ::: "memory");
        } else {
            XB_SPIN(xb_ld(&bar[XB_XGEN(b.x)]) == gen, bar);
            __builtin_amdgcn_fence(__ATOMIC_ACQUIRE, "agent");
            asm volatile("s_waitcnt vmcnt(0)" ::: "memory");
        }
    }
    __syncthreads();
}


__device__ __forceinline__ void run_phase(const Params& p, int ph, char* smem, int* s_item, int dup, int dryflag) {
#if PROBE_PHASE >= 0
  const int dry = dup ? dryflag : 0;
#else
  constexpr int dry = 0;
#endif
  if (ph == 4 * NPH_LAYER) { phase_norm(p, p.in[25], false, true); return; }
  const int layer = ph / NPH_LAYER, lp = ph % NPH_LAYER;
  bf16* sA = (bf16*)smem;
  bf16* sB = sA + 256 * 72;
  const int xcd = blockIdx.x & 7, bloc = blockIdx.x >> 3, nloc = gridDim.x >> 3;
  switch (lp) {
    case 0: {
      unsigned* ctr = p.counters + layer * 4 + 3 + dup * 16;
      for (;;) {
        int it = fetch_item(ctr, s_item);
        if (it >= CONV_ITEMS + FILT_ITEMS) break;
        if (it < FILT_ITEMS) { if (!dup || (PROBE_SUB & 1)) filt_item(p, layer, it, (float*)smem); }
        else { if (!dup || (PROBE_SUB & 2)) conv_tile(p, layer, it - FILT_ITEMS, (float*)smem); }
      }
      if (!dup || (PROBE_SUB & 4)) phase_norm(p, p.in[2] + layer * DM, layer == 0, false);
    } break;
    case 1: {
      for (int sq = bloc; sq < 16 * 31; sq += nloc) { int mt, nt; decode_tile(sq, 31, 16, 4, xcd, mt, nt); gemm1_tile(p, layer, mt, nt, sA, sB); }
    } break;
    case 2: {
      unsigned* ctr = p.counters + layer * 4 + 0 + dup * 16;
      for (;;) {
        int it = fetch_item(ctr, s_item);
        if (it >= 1024 + 4096) break;
        if (it < 1024) gla_item<false>(p, layer, it, *(GlaSm*)smem);
        else hy_u_tile(p, layer, it - 1024, (float*)smem);
      }
    } break;
    case 3: {
      unsigned* ctr = p.counters + layer * 4 + 1 + dup * 16;
      for (;;) {
        int it = fetch_item(ctr, s_item);
        if (it >= 2048 + 288 + 512) break;
        unsigned* scan_done = p.counters + 48 + layer;
        if (it < 288) { if (!dup || (PROBE_SUB & 4)) gla_scan_item(p, it, dry, dup ? nullptr : scan_done); continue; }
        it -= 288;
        if (it < 512) { if (!dup || (PROBE_SUB & 2)) attn_item(p, layer, it, (bf16*)smem, dry); }
        else if (it < 1024) { if (!dup || (PROBE_SUB & 1)) toeplitz_item(p, layer, 0, it - 512, (bf16*)smem, dry); }
        else if (it < 1536) {
          if (!dup) {
            if (threadIdx.x == 0) {
              while (__hip_atomic_load(scan_done, __ATOMIC_RELAXED, __HIP_MEMORY_SCOPE_AGENT) < 288u) __builtin_amdgcn_s_sleep(2);
              __builtin_amdgcn_fence(__ATOMIC_ACQUIRE, "agent");
              asm volatile("s_waitcnt vmcnt(0)" ::: "memory");
            }
            __syncthreads();
            gla_item<true>(p, layer, it - 1024, *(GlaSm*)smem);
          }
        }
        else if (it < 2048) { if (!dup || (PROBE_SUB & 1)) toeplitz_item(p, layer, 1, it - 1536, (bf16*)smem, dry); }
        else { if (!dup || (PROBE_SUB & 2)) attn_item(p, layer, it - 2048 + 512, (bf16*)smem, dry); }
      }
    } break;
    case 4: {
      unsigned* ctr = p.counters + layer * 4 + 2 + dup * 16;
      for (;;) {
        int it = fetch_item(ctr, s_item);
        if (it >= 4096) break;
        hy_fin_tile(p, layer, it, (float*)smem);
      }
    } break;
    case 5: {
      for (int sq = bloc; sq < 32 * 8; sq += nloc) { int mt, nt; decode_tile(sq, 8, 32, 8, xcd, mt, nt); merge_tile(p, mt, nt, sA, sB); }
    } break;
    case 6: {
      for (int sq = bloc; sq < 16 * 8; sq += nloc) { int mt, nt; decode_tile(sq, 8, 16, 4, xcd, mt, nt); resid_tile(p, p.merged, DM, p.WoT, DM, mt, nt, layer == 0, sA, sB, dry); }
    } break;
    case 7: {
      phase_norm(p, p.in[21] + layer * DM, false, false);
    } break;
    case 8: {
      for (int sq = bloc; sq < 16 * 44; sq += nloc) { int mt, nt; decode_tile(sq, 44, 16, 4, xcd, mt, nt); ffn1_tile(p, mt, nt, sA, sB); }
    } break;
    case 9: {
      for (int sq = bloc; sq < 16 * 8; sq += nloc) { int mt, nt; decode_tile(sq, 8, 16, 4, xcd, mt, nt); resid_tile(p, p.act, 2816, p.WfdT, 2816, mt, nt, false, sA, sB, dry); }
    } break;
  }
}

__global__ void __launch_bounds__(256, 2) mk(Params p, int ph_lo, int ph_hi, int coop) {
  __shared__ __attribute__((aligned(16))) char smem[73728];
  __shared__ int s_item;
  __shared__ uint4 xb_words;
  if (threadIdx.x == 0) xb_words = make_uint4(0u, 0u, 0u, 0u);
  __syncthreads();
  XcdBarrier xb = xcd_barrier_post(p.bar, (volatile LAS unsigned*)&xb_words);
  for (int ph = ph_lo; ph < ph_hi; ++ph) {
#if PROBE_PHASE >= 0
    const int reps = (ph < 4 * NPH_LAYER && (ph % NPH_LAYER) == PROBE_PHASE) ? 2 : 1;
    for (int rep = reps - 1; rep >= 0; --rep) {
      run_phase(p, ph, smem, &s_item, rep, coop);
      if (rep && coop) xcd_barrier(xb);
    }
#else
    run_phase(p, ph, smem, &s_item, 0, 0);
#endif
    if (coop && ph + 1 < ph_hi) {
      if (coop == 0x7fffffff) cg::this_grid().sync();
      xcd_barrier(xb);
    }
#if PROBE_PHASE == 99
    if (coop) xcd_barrier(xb);
#endif
  }
}

extern "C" void kernel_launch(void* const* d_in, const int* in_sizes, int n_in, void* d_out, int out_size, void* d_ws, size_t ws_size,
                              hipStream_t stream) {
  static int grid = 0;
  if (grid == 0) {
    int dev = 0, cus = 0, per_cu = 0;
    hipGetDevice(&dev);
    hipDeviceGetAttribute(&cus, hipDeviceAttributeMultiprocessorCount, dev);
    hipOccupancyMaxActiveBlocksPerMultiprocessor(&per_cu, mk, 256, 0);
    if (per_cu < 1) per_cu = 1;
    if (per_cu > 2) per_cu = 2;
    grid = cus * per_cu;
  }
  Params p{};
  for (int i = 0; i < 26; ++i) p.in[i] = (const float*)d_in[i];
  p.out = (float*)d_out;
  p.dryflag = 1;
  char* ws = (char*)d_ws;
  size_t off = 0;
  auto take = [&](size_t bytes) { char* r = ws + off; off += (bytes + 255) & ~(size_t)255; return r; };
  const size_t U = (size_t)T_TOK * 512 * 2;
  p.counters = (unsigned*)take(256);
  p.bar = (unsigned*)take((size_t)XCD_BAR_WORDS * 4);
  const size_t zero_bytes = off;
  p.sumsq = (float*)take((size_t)FILT_ITEMS * 1024 * 4);
  p.WinT = (bf16*)take((size_t)3968 * 1024 * 2);
  p.WgT = (bf16*)take((size_t)3072 * 1024 * 2);
  p.WbT = (bf16*)take((size_t)3 * 1024 * 512 * 2);
  p.WoT = (bf16*)take((size_t)1024 * 1024 * 2);
  p.WfguT = (bf16*)take((size_t)5632 * 1024 * 2);
  p.WfdT = (bf16*)take((size_t)1024 * 2816 * 2);
  p.h = (bf16*)take(2 * U);
  p.q = (bf16*)take(U);
  p.k = (bf16*)take(U / 4);
  p.vT = (bf16*)take(U / 4);
  p.hv = (bf16*)take(U);
  p.hx1 = (bf16*)take(U);
  p.hx2 = (bf16*)take(U);
  p.gq = (bf16*)take(U / 2);
  p.gk = (bf16*)take(U / 2);
  p.gv = (bf16*)take(U);
  p.gog = (bf16*)take(U);
  p.act = p.hv;
  p.of = p.hx1;
  p.glow = (float*)take((size_t)T_TOK * 32 * 4);
  p.uT = (bf16*)take(U);
  p.rhoP = (bf16*)take((size_t)512 * (2 * LP + 512) * 2);
  p.merged = p.uT;
  p.rhoS = (bf16*)take((size_t)512 * (2 * LS + 512) * 2);
  p.gstate = (bf16*)take((size_t)128 * 4 * 2 * 8192 * 2);
  p.gdecay = (float*)take((size_t)128 * 4 * 2 * 64 * 4);
  if (off > ws_size) { fprintf(stderr, "kernel_launch: workspace too small: need %zu have %zu\n", off, ws_size); return; }
  hipMemsetAsync(ws, 0, zero_bytes, stream);
  const int nph = 4 * NPH_LAYER + 1;
#if N_LAUNCH_MODE == 1
  int lo = 0, hi = nph, coop = 1;
  void* args[] = {&p, &lo, &hi, &coop};
  hipError_t e = hipLaunchCooperativeKernel((void*)mk, dim3(grid), dim3(256), args, 0, stream);
  if (e != hipSuccess) fprintf(stderr, "cooperative launch failed: %s (grid %d)\n", hipGetErrorString(e), grid);
#else
  for (int ph = 0; ph < nph; ++ph) mk<<<grid, 256, 0, stream>>>(p, ph, ph + 1, 0);
#endif
}
```
